# Optimizing an MI355X kernel written in HIP

```python
import jax, jax.numpy as jnp
from jax import lax
import numpy as np

D_MODEL = 1024
BATCH = 16
SEQ = 2048
DEPTH = 2

N_MIXERS = 2
FOURIER_GROUPS = 4
RWKV_HEAD_SIZE = 64
RWKV_HEADS = D_MODEL // RWKV_HEAD_SIZE
DECAY_LORA = 64
AAA_LORA = 64
GATE_LORA = 128
N_DIRS = 2
N_SHIFT_MIX = 6
D_FF = ((8 * D_MODEL + 3 * 256 - 1) // (3 * 256)) * 256
N_FOURIER_LAYERS = (DEPTH + 1) // 2
N_RWKV_LAYERS = DEPTH // 2
RMS_EPS = 1e-6
GN_EPS = RWKV_HEAD_SIZE * 1e-5

kernel_name = "fnet_rwkv7_hybrid_encoder"


def rmsnorm(x, g):
    xf = x.astype(jnp.float32)
    y = xf * lax.rsqrt(jnp.mean(xf * xf, axis=-1, keepdims=True) + RMS_EPS)
    return (y * g.astype(jnp.float32)).astype(x.dtype)


def fourier_mix(h, w_out):
    b, s, d = h.shape
    hg = h.reshape(b, s, FOURIER_GROUPS, d // FOURIER_GROUPS).astype(jnp.float32)
    f = jnp.fft.fftn(hg, axes=(1, 3), norm="ortho").real
    return f.reshape(b, s, d).astype(h.dtype) @ w_out


def split_heads(t):
    return t.reshape(t.shape[:-1] + (t.shape[-1] // RWKV_HEAD_SIZE, RWKV_HEAD_SIZE))


def wkv7_scan(r, w, k, v, kk, a, reverse):
    b, s, hh, n = r.shape
    xs = tuple(jnp.moveaxis(t, 1, 0) for t in (r, w, k, v, kk, a))

    def step(state, inp):
        r_t, w_t, k_t, v_t, kk_t, a_t = inp
        sk = jnp.einsum('bhvk,bhk->bhv', state, kk_t)
        state = (state * w_t[:, :, None, :]
                 - sk[..., None] * (kk_t * a_t)[:, :, None, :]
                 + v_t[..., None] * k_t[:, :, None, :])
        y_t = jnp.einsum('bhvk,bhk->bhv', state, r_t)
        return state, y_t

    state0 = jnp.zeros((b, hh, n, n), jnp.float32)
    _, ys = lax.scan(step, state0, xs, reverse=reverse)
    return jnp.moveaxis(ys, 0, 1)


def rwkv7_mix(h, mu, w_rkv, w_o, w0, w1, w2, a0, a1, a2, g1, g2, k_k, k_a, r_k, ln_w, ln_b):
    f32 = jnp.float32
    b, s, d = h.shape
    hp = jnp.pad(h, ((0, 0), (1, 1), (0, 0)))
    xx = 0.5 * (hp[:, :-2] + hp[:, 2:]) - h
    xs = h[None] + xx[None] * mu[:, None, None, :]
    rkv = jnp.einsum('cbsd,cde->cbse', xs[:3], w_rkv)
    r, k, v = rkv[0], rkv[1], rkv[2]
    xw, xa, xg = xs[3], xs[4], xs[5]
    w_lora = jnp.einsum('jbsr,jre->jbse', jnp.tanh(jnp.einsum('bsd,jdr->jbsr', xw, w1)), w2)
    w_log = -jax.nn.softplus(-(w0[:, None, None, :] + w_lora).astype(f32)) - 0.5
    decay = jnp.exp(-jnp.exp(w_log))
    a_lora = jnp.einsum('jbsr,jre->jbse', jnp.einsum('bsd,jdr->jbsr', xa, a1), a2)
    a = jax.nn.sigmoid((a0[:, None, None, :] + a_lora).astype(f32))
    g = jax.nn.sigmoid(xg @ g1) @ g2
    rf = split_heads(r.astype(f32))
    vf = split_heads(v.astype(f32))
    kf = k.astype(f32)
    kk = split_heads(kf * k_k.astype(f32))
    kk = kk * lax.rsqrt(jnp.maximum(jnp.sum(kk * kk, axis=-1, keepdims=True), 1e-24))
    k_dir = split_heads(kf[None] * (1.0 + (a - 1.0) * k_a.astype(f32)))
    a_h = split_heads(a)
    decay_h = split_heads(decay)
    y = (wkv7_scan(rf, decay_h[0], k_dir[0], vf, kk, a_h[0], False)
         + wkv7_scan(rf, decay_h[1], k_dir[1], vf, kk, a_h[1], True))
    mean = jnp.mean(y, axis=-1, keepdims=True)
    var = jnp.mean(jnp.square(y - mean), axis=-1, keepdims=True)
    yn = ((y - mean) * lax.rsqrt(var + GN_EPS)).reshape(b, s, d) * ln_w.astype(f32) + ln_b.astype(f32)
    bonus = jnp.sum(jnp.sum(rf[None] * k_dir * r_k.astype(f32), axis=-1, keepdims=True), axis=0) * vf
    out = (yn + bonus.reshape(b, s, d)).astype(h.dtype) * g
    return out @ w_o


def swiglu(h, w_gate, w_up, w_down):
    return (jax.nn.silu(h @ w_gate) * (h @ w_up)) @ w_down


def setup_inputs(seed: int = 0) -> dict:
    key = jax.random.key(seed)
    ks = jax.random.split(key, 26)
    f32 = jnp.float32
    D, F, NF, NR = D_MODEL, D_FF, N_FOURIER_LAYERS, N_RWKV_LAYERS

    def nrm(k, shape, scale):
        return jax.random.normal(k, shape, f32) * scale

    return {
        "x": nrm(ks[0], (BATCH, SEQ, D), 1.0),
        "norm_mix_g": 1.0 + nrm(ks[1], (DEPTH, D), 0.05),
        "norm_ffn_g": 1.0 + nrm(ks[2], (DEPTH, D), 0.05),
        "norm_final_g": 1.0 + nrm(ks[3], (D,), 0.05),
        "fno_w_out": nrm(ks[4], (NF, D, D), D ** -0.5),
        "rwkv_mu": jax.random.uniform(ks[5], (NR, N_SHIFT_MIX, D), f32),
        "rwkv_w_rkv": nrm(ks[6], (NR, 3, D, D), D ** -0.5),
        "rwkv_w_o": nrm(ks[7], (NR, D, D), D ** -0.5),
        "rwkv_w0": jax.random.uniform(ks[8], (NR, N_DIRS, D), f32, -4.0, 1.0),
        "rwkv_w1": nrm(ks[9], (NR, N_DIRS, D, DECAY_LORA), D ** -0.5),
        "rwkv_w2": nrm(ks[10], (NR, N_DIRS, DECAY_LORA, D), 0.3 * DECAY_LORA ** -0.5),
        "rwkv_a0": nrm(ks[11], (NR, N_DIRS, D), 0.3),
        "rwkv_a1": nrm(ks[12], (NR, N_DIRS, D, AAA_LORA), D ** -0.5),
        "rwkv_a2": nrm(ks[13], (NR, N_DIRS, AAA_LORA, D), 0.3 * AAA_LORA ** -0.5),
        "rwkv_g1": nrm(ks[14], (NR, D, GATE_LORA), D ** -0.5),
        "rwkv_g2": nrm(ks[15], (NR, GATE_LORA, D), GATE_LORA ** -0.5),
        "rwkv_k_k": 0.85 + nrm(ks[16], (NR, D), 0.05),
        "rwkv_k_a": 1.0 + nrm(ks[17], (NR, D), 0.05),
        "rwkv_r_k": nrm(ks[18], (NR, RWKV_HEADS, RWKV_HEAD_SIZE), 0.1),
        "rwkv_ln_w": 1.0 + nrm(ks[19], (NR, D), 0.05),
        "rwkv_ln_b": nrm(ks[20], (NR, D), 0.01),
        "ffn_w_gate": nrm(ks[21], (DEPTH, D, F), D ** -0.5),
        "ffn_w_up": nrm(ks[22], (DEPTH, D, F), D ** -0.5),
        "ffn_w_down": nrm(ks[23], (DEPTH, F, D), F ** -0.5),
    }


def reference(x, norm_mix_g, norm_ffn_g, norm_final_g, fno_w_out, rwkv_mu, rwkv_w_rkv, rwkv_w_o,
              rwkv_w0, rwkv_w1, rwkv_w2, rwkv_a0, rwkv_a1, rwkv_a2, rwkv_g1, rwkv_g2,
              rwkv_k_k, rwkv_k_a, rwkv_r_k, rwkv_ln_w, rwkv_ln_b, ffn_w_gate, ffn_w_up, ffn_w_down):
    for i in range(DEPTH):
        h = rmsnorm(x, norm_mix_g[i])
        j = i // N_MIXERS
        if i % N_MIXERS == 0:
            x = x + fourier_mix(h, fno_w_out[j])
        else:
            x = x + rwkv7_mix(h, rwkv_mu[j], rwkv_w_rkv[j], rwkv_w_o[j],
                              rwkv_w0[j], rwkv_w1[j], rwkv_w2[j],
                              rwkv_a0[j], rwkv_a1[j], rwkv_a2[j],
                              rwkv_g1[j], rwkv_g2[j], rwkv_k_k[j], rwkv_k_a[j],
                              rwkv_r_k[j], rwkv_ln_w[j], rwkv_ln_b[j])
        h = rmsnorm(x, norm_ffn_g[i])
        x = x + swiglu(h, ffn_w_gate[i], ffn_w_up[i], ffn_w_down[i])
    return rmsnorm(x, norm_final_g)
```

```cpp
#include <hip/hip_runtime.h>
#include <hip/hip_cooperative_groups.h>
#include <cstdio>
namespace cg = cooperative_groups;

#define LAS __attribute__((address_space(3)))
typedef unsigned short u16;
typedef short bf16x8 __attribute__((ext_vector_type(8)));
typedef float f32x4 __attribute__((ext_vector_type(4)));
typedef unsigned u32x4 __attribute__((ext_vector_type(4)));
typedef unsigned u32x2 __attribute__((ext_vector_type(2)));
typedef _Float16 h16;
typedef _Float16 h16x2 __attribute__((ext_vector_type(2)));
typedef _Float16 h16x8 __attribute__((ext_vector_type(8)));

constexpr int D = 1024, SEQ = 2048, NB = 16, M = NB * SEQ, FF = 2816;
constexpr size_t MiB = (size_t)1 << 20;
constexpr size_t W_WOUT = 0, W_GU0 = 2 * MiB, W_GU1 = 13 * MiB, W_D0 = 24 * MiB, W_D1 = 24 * MiB + 5632 * 1024, W_RKV = 35 * MiB, W_WO = 41 * MiB,
                 W_LI = 43 * MiB, W_LO = 45 * MiB, W_DFTC = 45 * MiB + 512 * 1024, W_WS = 46 * MiB, W_CTL = 63 * MiB;
constexpr size_t A_H0 = 64 * MiB, A_YT = 128 * MiB, A_F = 256 * MiB, A_ACT0 = 128 * MiB;
constexpr size_t A_HX = 64 * MiB, A_XS = 192 * MiB, A_MID = 384 * MiB, A_R = 64 * MiB, A_K = 128 * MiB, A_V = 416 * MiB, A_YF = 192 * MiB, A_YB = 256 * MiB,
                 A_G = 320 * MiB, A_BON = 480 * MiB, A_GATED = 64 * MiB, A_H1 = 128 * MiB, A_ACT1 = 192 * MiB;
constexpr size_t A_XF = 64 * MiB;
constexpr size_t A_CORR = 484 * MiB;
constexpr size_t WS_NEED = 485 * MiB;
constexpr int GT_OFF = 131072 + 64, LDS_BYTES = GT_OFF + 8 * 3072;
constexpr int NPHASE = 18;

struct Params { const float* in[24]; float* out; unsigned char* ws; int ph_lo, ph_hi, coop, pad; };

typedef __bf16 bf16x2n __attribute__((ext_vector_type(2)));
__device__ __forceinline__ unsigned cvt_pk_bf16(float lo, float hi) { const bf16x2n v = {(__bf16)lo, (__bf16)hi}; return __builtin_bit_cast(unsigned, v); }
__device__ __forceinline__ unsigned cvt_pk_f16(float lo, float hi) { h16x2 p = {(h16)lo, (h16)hi}; return __builtin_bit_cast(unsigned, p); }
__device__ __forceinline__ float bf2f(unsigned b) { return __uint_as_float(b << 16); }
__device__ __forceinline__ float wave_sum(float v) {
#pragma unroll
    for (int o = 1; o < 64; o <<= 1) v += __shfl_xor(v, o);
    return v;
}
__device__ __forceinline__ float fsigmoid(float x) { return __builtin_amdgcn_rcpf(1.0f + __expf(-x)); }
__device__ __forceinline__ float ftanh(float x) { return 1.0f - 2.0f * __builtin_amdgcn_rcpf(1.0f + __expf(2.0f * x)); }

namespace pg8 {
constexpr int BM = 256, BK = 64, HALF = 128, HTB = HALF * BK * 2, NXCD = 8, WGM = 8;
__device__ __forceinline__ int lds_byte(int r, int c) { const int st = (r >> 4) * 2 + (c >> 5), rr = r & 15, cc = c & 31, ob = rr * 64 + cc * 2; return st * 1024 + (ob ^ (((ob >> 9) & 1) << 5)); }
__device__ __forceinline__ void stage_rc(int b, int& R, int& C) { const int st = b / 1024, sb = b % 1024, swz = sb ^ (((sb >> 9) & 1) << 5); R = (st >> 1) * 16 + swz / 64; C = (st & 1) * 32 + (swz % 64) / 2; }
__device__ __forceinline__ int perm32(int rho) { const int n = rho >> 4, i = rho & 15; return 8 * (i >> 2) + 4 * n + (i & 3); }

struct Unit { const char* A; const char* B; const char* B2; int pm, pn, bt; };
struct Sched {
    const char* A0; const char* B0;
    long aM, aG, aB1, aB2, bN, bB1, bB2;
    int nM, nN, nB, nB2, aGrp, lda, ldb, K, G, c;
    long mirTop;
    __device__ bool next(int i, Unit& u) const {
        const int nMt = nM * nB, nwg = nMt * nN;
        const long L = (long)i * G + c; if (L >= nwg) return false;
        int wgid = (int)L; { const int q = nwg / NXCD, r = nwg % NXCD, xcd = wgid % NXCD, off = wgid / NXCD; wgid = (xcd < r ? xcd * (q + 1) : r * (q + 1) + (xcd - r) * q) + off; }
        const int nig = WGM * nN, gid = wgid / nig, fm = gid * WGM, gsz = (nMt - fm) < WGM ? (nMt - fm) : WGM;
        const int PM = fm + ((wgid % nig) % gsz), pn = (wgid % nig) / gsz;
        u.bt = PM / nM; u.pm = PM % nM; u.pn = pn;
        const int b1 = u.bt / nB2, b2 = u.bt % nB2;
        u.A = A0 + (long)b1 * aB1 + (long)b2 * aB2 + (long)u.pm * aM + (long)(pn / aGrp) * aG;
        u.B = B0 + (long)b1 * bB1 + (long)b2 * bB2 + (long)pn * bN;
        u.B2 = B0 + (long)b1 * bB1 + (long)b2 * bB2 + mirTop - (long)pn * bN;
        return true;
    }
};

template <bool RES_F32> struct EpiRes {
    static constexpr bool PERM = true;
    const void* res; u16* out;
    __device__ __forceinline__ void operator()(const f32x4 (&acc)[2][2][4][2], const Unit& u, int wr, int wc, int fr, int fq) const {
        const int row0 = u.pm * BM + wr * 64 + fr, col0 = u.pn * BM + wc * 32 + 8 * fq;
        if (RES_F32) {
#pragma unroll
            for (int ai = 0; ai < 2; ++ai) {
                f32x4 rf[4][2][2];
#pragma unroll
                for (int m = 0; m < 4; ++m)
#pragma unroll
                    for (int bj = 0; bj < 2; ++bj) { const float* rp = (const float*)res + (size_t)(row0 + ai * HALF + m * 16) * D + col0 + bj * HALF; rf[m][bj][0] = *(const f32x4*)rp; rf[m][bj][1] = *(const f32x4*)(rp + 4); }
#pragma unroll
                for (int m = 0; m < 4; ++m)
#pragma unroll
                    for (int bj = 0; bj < 2; ++bj) { const f32x4 v0 = acc[ai][bj][m][0] + rf[m][bj][0], v1 = acc[ai][bj][m][1] + rf[m][bj][1];
                        u32x4 w; w.x = cvt_pk_bf16(v0[0], v0[1]); w.y = cvt_pk_bf16(v0[2], v0[3]); w.z = cvt_pk_bf16(v1[0], v1[1]); w.w = cvt_pk_bf16(v1[2], v1[3]);
                        *(u32x4*)(out + (size_t)(row0 + ai * HALF + m * 16) * D + col0 + bj * HALF) = w; }
            }
        } else {
            u32x4 rb[2][4][2];
#pragma unroll
            for (int ai = 0; ai < 2; ++ai)
#pragma unroll
                for (int m = 0; m < 4; ++m)
#pragma unroll
                    for (int bj = 0; bj < 2; ++bj) rb[ai][m][bj] = *(const u32x4*)((const u16*)res + (size_t)(row0 + ai * HALF + m * 16) * D + col0 + bj * HALF);
#pragma unroll
            for (int ai = 0; ai < 2; ++ai)
#pragma unroll
                for (int m = 0; m < 4; ++m)
#pragma unroll
                    for (int bj = 0; bj < 2; ++bj) { const u32x4 t = rb[ai][m][bj];
                        const f32x4 r0 = {bf2f(t.x & 0xffffu), bf2f(t.x >> 16), bf2f(t.y & 0xffffu), bf2f(t.y >> 16)}, r1 = {bf2f(t.z & 0xffffu), bf2f(t.z >> 16), bf2f(t.w & 0xffffu), bf2f(t.w >> 16)};
                        const f32x4 v0 = acc[ai][bj][m][0] + r0, v1 = acc[ai][bj][m][1] + r1;
                        u32x4 w; w.x = cvt_pk_bf16(v0[0], v0[1]); w.y = cvt_pk_bf16(v0[2], v0[3]); w.z = cvt_pk_bf16(v1[0], v1[1]); w.w = cvt_pk_bf16(v1[2], v1[3]);
                        *(u32x4*)(out + (size_t)(row0 + ai * HALF + m * 16) * D + col0 + bj * HALF) = w; }
        }
    }
};
struct Epi16 {
    static constexpr bool PERM = true;
    u16 *O0, *O1, *O2; int ldc, grp, mode; long bstride; const float* corr;
    __device__ __forceinline__ void operator()(const f32x4 (&acc)[2][2][4][2], const Unit& u, int wr, int wc, int fr, int fq) const {
        const int g = u.pn / grp, colt = (u.pn % grp) * BM;
        u16* base = (g == 0 ? O0 : (g == 1 ? O1 : O2)) + (size_t)u.bt * bstride;
        const int row0 = u.pm * BM + wr * 64 + fr, col0 = colt + wc * 32 + 8 * fq;
        f32x4 cr[2][2] = {};
        if (mode == 3) { const float sg = (fr & 1) ? -1.f : 1.f;
#pragma unroll
            for (int bj = 0; bj < 2; ++bj) { const float* cp = corr + (size_t)u.bt * D + col0 + bj * HALF; cr[bj][0] = *(const f32x4*)cp * sg; cr[bj][1] = *(const f32x4*)(cp + 4) * sg; } }
#pragma unroll
        for (int ai = 0; ai < 2; ++ai)
#pragma unroll
            for (int m = 0; m < 4; ++m) { u16* rowp = base + (size_t)(row0 + ai * HALF + m * 16) * ldc + col0;
#pragma unroll
                for (int bj = 0; bj < 2; ++bj) { f32x4 v0 = acc[ai][bj][m][0], v1 = acc[ai][bj][m][1]; u32x4 w;
                    if (mode == 3) { v0 = v0 + cr[bj][0]; v1 = v1 + cr[bj][1]; }
                    if (mode == 1) { w.x = cvt_pk_f16(v0[0], v0[1]); w.y = cvt_pk_f16(v0[2], v0[3]); w.z = cvt_pk_f16(v1[0], v1[1]); w.w = cvt_pk_f16(v1[2], v1[3]); }
                    else {
                        if (mode == 2) { const int sel = u.pn * 2 + bj;
                            if (sel == 0) {
#pragma unroll
                                for (int j = 0; j < 4; ++j) { v0[j] = ftanh(v0[j]); v1[j] = ftanh(v1[j]); } }
                            else if (sel >= 2) {
#pragma unroll
                                for (int j = 0; j < 4; ++j) { v0[j] = fsigmoid(v0[j]); v1[j] = fsigmoid(v1[j]); } } }
                        w.x = cvt_pk_bf16(v0[0], v0[1]); w.y = cvt_pk_bf16(v0[2], v0[3]); w.z = cvt_pk_bf16(v1[0], v1[1]); w.w = cvt_pk_bf16(v1[2], v1[3]); }
                    *(u32x4*)(rowp + bj * HALF) = w; } }
    }
};
struct EpiFold {
    static constexpr bool PERM = true;
    u16* O;
    __device__ __forceinline__ void operator()(const f32x4 (&acc)[2][2][4][2], const Unit& u, int wr, int wc, int fr, int fq) const {
        const int row0 = u.pm * BM + wr * 64 + fr, col0 = u.pn * HALF + wc * 32 + 8 * fq;
        const float sg = (fr & 1) ? -1.f : 1.f; const bool j0 = (u.pn == 0) && (wc == 0) && (fq == 0);
        u16* base = O + (size_t)u.bt * (512 * 1024);
#pragma unroll
        for (int ai = 0; ai < 2; ++ai)
#pragma unroll
            for (int m = 0; m < 4; ++m) { f32x4 v0 = acc[ai][0][m][0] + acc[ai][1][m][0] * sg, v1 = acc[ai][0][m][1] + acc[ai][1][m][1] * sg;
                if (j0) v0[0] = (fr & 1) ? 0.f : acc[ai][0][m][0][0];
                u32x4 w; w.x = cvt_pk_bf16(v0[0], v0[1]); w.y = cvt_pk_bf16(v0[2], v0[3]); w.z = cvt_pk_bf16(v1[0], v1[1]); w.w = cvt_pk_bf16(v1[2], v1[3]);
                *(u32x4*)(base + (size_t)(row0 + ai * HALF + m * 16) * 1024 + col0) = w; }
    }
};
struct EpiGLU {
    static constexpr bool PERM = true;
    u16* O;
    __device__ __forceinline__ void operator()(const f32x4 (&acc)[2][2][4][2], const Unit& u, int wr, int wc, int fr, int fq) const {
        const int row0 = u.pm * BM + wr * 64 + fr, col0 = u.pn * HALF + wc * 32 + 8 * fq;
#pragma unroll
        for (int ai = 0; ai < 2; ++ai)
#pragma unroll
            for (int m = 0; m < 4; ++m) { u16* rowp = O + (size_t)(row0 + ai * HALF + m * 16) * FF + col0; float o[8];
#pragma unroll
                for (int n = 0; n < 2; ++n)
#pragma unroll
                    for (int j = 0; j < 4; ++j) { const float g = acc[ai][0][m][n][j], up = acc[ai][1][m][n][j]; o[n * 4 + j] = g * fsigmoid(g) * up; }
                u32x4 w; w.x = cvt_pk_bf16(o[0], o[1]); w.y = cvt_pk_bf16(o[2], o[3]); w.z = cvt_pk_bf16(o[4], o[5]); w.w = cvt_pk_bf16(o[6], o[7]);
                *(u32x4*)rowp = w; }
    }
};

template <class Epi, bool MIRROR = false>
__device__ __forceinline__ void gemm_phase(LAS unsigned char* lds, const Sched& S, const Epi& E) {
    const int tid = threadIdx.x, wid = __builtin_amdgcn_readfirstlane(tid >> 6), lane = tid & 63, wr = wid >> 2, wc = wid & 3, fr = lane & 15, fq = lane >> 4;
    const int K = S.K, nt = K / BK;
    unsigned voffA[2], voffB[2]; int voffB2[2];
#pragma unroll
    for (int i = 0; i < 2; ++i) { int R, C; stage_rc(tid * 16 + i * 8192, R, C); const int Rb = Epi::PERM ? ((R & ~31) + perm32(R & 31)) : R;
        voffA[i] = (unsigned)(R * S.lda + C) * 2u; voffB[i] = (unsigned)(Rb * S.ldb + C) * 2u; voffB2[i] = (C - Rb * S.ldb) * 2; }
    const size_t kstep = (size_t)(BK * 2);
    const size_t hstepA = (size_t)HALF * S.lda * 2, hstepB = (size_t)HALF * S.ldb * 2;
    const unsigned ldsw = (unsigned)wid * 1024u;
    const int aoff = lds_byte(wr * 64 + fr, fq * 8), boff = lds_byte(wc * 32 + fr, fq * 8);
#define PG8_SA(b, h) (((b) * 2 + (h)) * HTB)
#define PG8_SB(b, h) ((4 + (b) * 2 + (h)) * HTB)
#define PG8_STAGE(bufoff, gbase, voff) do { _Pragma("unroll") for (int _i = 0; _i < 2; ++_i) \
        __builtin_amdgcn_global_load_lds((const unsigned*)((const char*)(gbase) + (voff)[_i]), (LAS unsigned*)(lds + (bufoff) + ldsw + _i * 8192), 16, 0, 0); } while (0)
#define PG8_STAGE_BH(bufoff, p1, p2) do { if (MIRROR) { _Pragma("unroll") for (int _i = 0; _i < 2; ++_i) \
        __builtin_amdgcn_global_load_lds((const unsigned*)((const char*)(p2) + voffB2[_i]), (LAS unsigned*)(lds + (bufoff) + ldsw + _i * 8192), 16, 0, 0); } else PG8_STAGE(bufoff, (p1) + hstepB, voffB); } while (0)
#define PG8_LDA(dst, b, h) do { _Pragma("unroll") for (int m = 0; m < 4; ++m) _Pragma("unroll") for (int k = 0; k < 2; ++k) dst[m][k] = *(const LAS bf16x8*)(lds + PG8_SA(b, h) + aoff + m * 2048 + k * 1024); } while (0)
#define PG8_LDB(dst, b, h) do { _Pragma("unroll") for (int n = 0; n < 2; ++n) _Pragma("unroll") for (int k = 0; k < 2; ++k) dst[n][k] = *(const LAS bf16x8*)(lds + PG8_SB(b, h) + boff + n * 2048 + k * 1024); } while (0)
#define PG8_MMA(ai, bj, At, Bt) do { __builtin_amdgcn_s_setprio(1); _Pragma("unroll") for (int m = 0; m < 4; ++m) _Pragma("unroll") for (int n = 0; n < 2; ++n) _Pragma("unroll") for (int k = 0; k < 2; ++k) \
        acc[ai][bj][m][n] = __builtin_amdgcn_mfma_f32_16x16x32_bf16(Bt[n][k], At[m][k], acc[ai][bj][m][n], 0, 0, 0); __builtin_amdgcn_s_setprio(0); } while (0)
#define PG8_WAIT_V(n) asm volatile("s_waitcnt vmcnt(" #n ")" ::: "memory")
#define PG8_WAIT_L(n) asm volatile("s_waitcnt lgkmcnt(" #n ")" ::: "memory")
#define PG8_BAR __builtin_amdgcn_s_barrier()
#define PG8_SCHED __builtin_amdgcn_sched_barrier(0)
    Unit cur, nxt; int ui = 0;
    if (!S.next(0, cur)) return;
    f32x4 acc[2][2][4][2];
#pragma unroll
    for (int a = 0; a < 2; ++a)
#pragma unroll
        for (int b = 0; b < 2; ++b)
#pragma unroll
            for (int m = 0; m < 4; ++m)
#pragma unroll
                for (int n = 0; n < 2; ++n) acc[a][b][m][n] = (f32x4){0.f, 0.f, 0.f, 0.f};
    bf16x8 At[4][2], B0[2][2], B1[2][2];
    const char* cA = cur.A; const char* cB = cur.B; const char* cB2 = cur.B2;
    PG8_STAGE(PG8_SB(0, 0), cB, voffB); PG8_STAGE(PG8_SA(0, 0), cA, voffA); PG8_STAGE_BH(PG8_SB(0, 1), cB, cB2); PG8_STAGE(PG8_SA(0, 1), cA + hstepA, voffA);
    if (wr == 1) PG8_BAR;
    PG8_WAIT_V(4); PG8_BAR;
    PG8_STAGE(PG8_SB(1, 0), cB + kstep, voffB); PG8_STAGE(PG8_SA(1, 0), cA + kstep, voffA); PG8_STAGE_BH(PG8_SB(1, 1), cB + kstep, cB2 + kstep);
    PG8_WAIT_V(6); PG8_BAR;
    for (;;) {
        const bool has_next = S.next(ui + 1, nxt);
        const char* nA = has_next ? nxt.A : cA; const char* nB = has_next ? nxt.B : cB; const char* nB2 = has_next ? nxt.B2 : cB2;
        for (int t = 0; t < nt; t += 2) {
            const bool last = (t == nt - 2);
            const char* a1 = cA + (size_t)(t + 1) * kstep;
            const char* a2 = last ? nA : cA + (size_t)(t + 2) * kstep; const char* b2 = last ? nB : cB + (size_t)(t + 2) * kstep;
            const char* a3 = a2 + kstep; const char* b3 = b2 + kstep;
            const char* b2m = last ? nB2 : cB2 + (size_t)(t + 2) * kstep; const char* b3m = b2m + kstep;
            PG8_LDB(B0, 0, 0); PG8_SCHED; PG8_LDA(At, 0, 0); PG8_STAGE(PG8_SA(1, 1), a1 + hstepA, voffA);
            PG8_WAIT_L(8); PG8_BAR; PG8_WAIT_L(0); PG8_MMA(0, 0, At, B0); PG8_BAR; PG8_SCHED;
            PG8_LDB(B1, 0, 1); PG8_STAGE(PG8_SB(0, 0), b2, voffB);
            PG8_BAR; PG8_WAIT_L(0); PG8_MMA(0, 1, At, B1); PG8_BAR;
            PG8_LDA(At, 0, 1); PG8_STAGE(PG8_SA(0, 0), a2, voffA);
            PG8_BAR; PG8_WAIT_L(0); PG8_MMA(1, 0, At, B0); PG8_BAR; PG8_SCHED;
            PG8_STAGE_BH(PG8_SB(0, 1), b2, b2m);
            PG8_WAIT_V(6); PG8_BAR; PG8_MMA(1, 1, At, B1); PG8_BAR;
            PG8_LDB(B0, 1, 0); PG8_SCHED; PG8_LDA(At, 1, 0); PG8_STAGE(PG8_SA(0, 1), a2 + hstepA, voffA);
            PG8_WAIT_L(8); PG8_BAR; PG8_WAIT_L(0); PG8_MMA(0, 0, At, B0); PG8_BAR; PG8_SCHED;
            PG8_LDB(B1, 1, 1); PG8_STAGE(PG8_SB(1, 0), b3, voffB);
            PG8_BAR; PG8_WAIT_L(0); PG8_MMA(0, 1, At, B1); PG8_BAR;
            PG8_LDA(At, 1, 1); PG8_STAGE(PG8_SA(1, 0), a3, voffA);
            PG8_BAR; PG8_WAIT_L(0); PG8_MMA(1, 0, At, B0); PG8_BAR; PG8_SCHED;
            PG8_STAGE_BH(PG8_SB(1, 1), b3, b3m);
            PG8_WAIT_V(6); PG8_BAR; PG8_MMA(1, 1, At, B1); PG8_BAR;
        }
        E(acc, cur, wr, wc, fr, fq);
        if (!has_next) break;
#pragma unroll
        for (int a = 0; a < 2; ++a)
#pragma unroll
            for (int b = 0; b < 2; ++b)
#pragma unroll
                for (int m = 0; m < 4; ++m)
#pragma unroll
                    for (int n = 0; n < 2; ++n) acc[a][b][m][n] = (f32x4){0.f, 0.f, 0.f, 0.f};
        cur = nxt; cA = nA; cB = nB; cB2 = nB2; ++ui;
    }
    PG8_WAIT_V(0);
    if (wr == 0) PG8_BAR;
    PG8_BAR;
#undef PG8_SA
#undef PG8_SB
#undef PG8_STAGE
#undef PG8_STAGE_BH
#undef PG8_LDA
#undef PG8_LDB
#undef PG8_MMA
#undef PG8_WAIT_V
#undef PG8_WAIT_L
#undef PG8_BAR
#undef PG8_SCHED
}
}

__device__ __forceinline__ void tr_tile(const float* __restrict__ W, int ldw, int k0, int n0, u16* WT, int ldt, int drow0, int dcol0, const float* kscale, LAS float* scr, int lane) {
#pragma unroll 8
    for (int i = 0; i < 32; ++i) { const int kk = 2 * i + (lane >> 5); float v = W[(size_t)(k0 + kk) * ldw + n0 + (lane & 31)]; if (kscale) v *= kscale[k0 + kk]; scr[kk * 33 + (lane & 31)] = v; }
    asm volatile("s_waitcnt lgkmcnt(0)" ::: "memory");
    const int c = lane & 7;
#pragma unroll
    for (int j = 0; j < 4; ++j) { const int n = (lane >> 3) + 8 * j; const LAS float* s = scr + (8 * c) * 33 + n;
        u32x4 o; o.x = cvt_pk_bf16(s[0 * 33], s[1 * 33]); o.y = cvt_pk_bf16(s[2 * 33], s[3 * 33]); o.z = cvt_pk_bf16(s[4 * 33], s[5 * 33]); o.w = cvt_pk_bf16(s[6 * 33], s[7 * 33]);
        *(u32x4*)(WT + (size_t)(drow0 + n) * ldt + dcol0 + 8 * c) = o; }
    asm volatile("s_waitcnt lgkmcnt(0)" ::: "memory");
}

#define VIDX(lane, k) (2 * (lane) + 128 * ((k) >> 1) + ((k) & 1))
__device__ __forceinline__ void rms_row(const float* xrow, const f32x4 (&gv)[4], f32x4 (&v)[4], int lane) {
    const f32x4* xr = (const f32x4*)xrow; float s = 0.f;
#pragma unroll
    for (int k = 0; k < 4; ++k) { v[k] = xr[VIDX(lane, k)]; s += (v[k].x * v[k].x + v[k].y * v[k].y) + (v[k].z * v[k].z + v[k].w * v[k].w); }
    const float rstd = rsqrtf(wave_sum(s) * (1.f / D) + 1e-6f);
#pragma unroll
    for (int k = 0; k < 4; ++k) v[k] = v[k] * rstd * gv[k];
}
__device__ __forceinline__ void rms_row_b(const u16* xrow, const f32x4 (&gv)[4], f32x4 (&v)[4], int lane) {
    const u32x4* xr = (const u32x4*)xrow + lane; float s = 0.f;
#pragma unroll
    for (int j = 0; j < 2; ++j) { const u32x4 t = xr[64 * j];
        v[2 * j] = (f32x4){bf2f(t.x & 0xffffu), bf2f(t.x >> 16), bf2f(t.y & 0xffffu), bf2f(t.y >> 16)}; v[2 * j + 1] = (f32x4){bf2f(t.z & 0xffffu), bf2f(t.z >> 16), bf2f(t.w & 0xffffu), bf2f(t.w >> 16)}; }
#pragma unroll
    for (int k = 0; k < 4; ++k) s += (v[k].x * v[k].x + v[k].y * v[k].y) + (v[k].z * v[k].z + v[k].w * v[k].w);
    const float rstd = rsqrtf(wave_sum(s) * (1.f / D) + 1e-6f);
#pragma unroll
    for (int k = 0; k < 4; ++k) v[k] = v[k] * rstd * gv[k];
}
__device__ __forceinline__ void store_row_bf16(u16* orow, const f32x4 (&v)[4], int lane) {
    u32x4* o16 = (u32x4*)orow + lane;
#pragma unroll
    for (int j = 0; j < 2; ++j) { u32x4 w; w.x = cvt_pk_bf16(v[2 * j].x, v[2 * j].y); w.y = cvt_pk_bf16(v[2 * j].z, v[2 * j].w); w.z = cvt_pk_bf16(v[2 * j + 1].x, v[2 * j + 1].y); w.w = cvt_pk_bf16(v[2 * j + 1].z, v[2 * j + 1].w); o16[64 * j] = w; }
}

__device__ __forceinline__ void phase_rmsnorm_bf16(const float* x, const float* g, u16* out, int ostride) {
    const int lane = threadIdx.x & 63, gw = blockIdx.x * 8 + (threadIdx.x >> 6), NGW = gridDim.x * 8;
    f32x4 gv[4];
#pragma unroll
    for (int j = 0; j < 4; ++j) gv[j] = ((const f32x4*)g)[VIDX(lane, j)];
    for (int row = gw; row < M; row += NGW) { f32x4 v[4]; rms_row(x + (size_t)row * D, gv, v, lane); store_row_bf16(out + (size_t)row * ostride, v, lane); }
}
__device__ __forceinline__ void phase_rmsnorm_b2b(const u16* x, const float* g, u16* out) {
    const int lane = threadIdx.x & 63, gw = blockIdx.x * 8 + (threadIdx.x >> 6), NGW = gridDim.x * 8;
    f32x4 gv[4];
#pragma unroll
    for (int j = 0; j < 4; ++j) gv[j] = ((const f32x4*)g)[VIDX(lane, j)];
    for (int row = gw; row < M; row += NGW) { f32x4 v[4]; rms_row_b(x + (size_t)row * D, gv, v, lane); store_row_bf16(out + (size_t)row * D, v, lane); }
}
__device__ __forceinline__ void phase_rmsnorm_final(const u16* x, float* out, const float* g) {
    const int lane = threadIdx.x & 63, gw = blockIdx.x * 8 + (threadIdx.x >> 6), NGW = gridDim.x * 8;
    f32x4 gv[4];
#pragma unroll
    for (int j = 0; j < 4; ++j) gv[j] = ((const f32x4*)g)[VIDX(lane, j)];
    for (int row = gw; row < M; row += NGW) { f32x4 v[4]; rms_row_b(x + (size_t)row * D, gv, v, lane); f32x4* o = (f32x4*)(out + (size_t)row * D);
#pragma unroll
        for (int j = 0; j < 4; ++j) o[VIDX(lane, j)] = v[j]; }
}

__device__ __forceinline__ void phase_prep(const Params& p, LAS unsigned char* lds) {
    const int tid = threadIdx.x, lane = tid & 63, wave = tid >> 6;
    const int gw = blockIdx.x * 8 + wave, NGW = gridDim.x * 8;
    const int gt = blockIdx.x * 512 + tid, NGT = gridDim.x * 512;
    unsigned char* ws = p.ws;
    LAS float* scr = (LAS float*)(lds + wave * 8448);
#define TR_JOB(SRC, LDW, KK, NN, DST, LDT, DROWEXPR, DCOL0, KSCALE) \
    { const int nblk = (NN) / 32, nit = ((KK) / 64) * nblk; if (it < nit) { const int kb = it / nblk, nb = it % nblk, k0 = 64 * kb, n0 = 32 * nb; \
        tr_tile(SRC, LDW, k0, n0, (u16*)(DST), LDT, (DROWEXPR), (DCOL0) + k0, KSCALE, scr, lane); continue; } it -= nit; }
    constexpr int NIT_SQ = 16 * 32, NIT_GU = 16 * 88, NIT_DN = 44 * 32, NIT_L64 = 16 * 2, NIT_L128 = 16 * 4, NIT_G2 = 2 * 32;
    constexpr int NITEMS = NIT_SQ + 2 * (2 * NIT_GU + NIT_DN) + 3 * NIT_SQ + NIT_SQ + 2 * (4 * NIT_L64) + 2 * NIT_L128 + NIT_G2;
    for (int it0 = gw; it0 < NITEMS; it0 += NGW) {
        int it = it0;
        TR_JOB(p.in[4], D, D, D, ws + W_WOUT, D, n0, 0, nullptr)
        TR_JOB(p.in[21], FF, D, FF, ws + W_GU0, D, (n0 / 128) * 256 + (n0 % 128), 0, nullptr)
        TR_JOB(p.in[22], FF, D, FF, ws + W_GU0, D, (n0 / 128) * 256 + 128 + (n0 % 128), 0, nullptr)
        TR_JOB(p.in[21] + (size_t)D * FF, FF, D, FF, ws + W_GU1, D, (n0 / 128) * 256 + (n0 % 128), 0, nullptr)
        TR_JOB(p.in[22] + (size_t)D * FF, FF, D, FF, ws + W_GU1, D, (n0 / 128) * 256 + 128 + (n0 % 128), 0, nullptr)
        TR_JOB(p.in[23], D, FF, D, ws + W_D0, FF, n0, 0, nullptr)
        TR_JOB(p.in[23] + (size_t)D * FF, D, FF, D, ws + W_D1, FF, n0, 0, nullptr)
        TR_JOB(p.in[6], D, D, D, ws + W_RKV, D, n0, 0, nullptr)
        TR_JOB(p.in[6] + (size_t)D * D, D, D, D, ws + W_RKV, D, 1024 + n0, 0, nullptr)
        TR_JOB(p.in[6] + (size_t)2 * D * D, D, D, D, ws + W_RKV, D, 2048 + n0, 0, nullptr)
        TR_JOB(p.in[7], D, D, D, ws + W_WO, D, n0, 0, nullptr)
        TR_JOB(p.in[9], 64, D, 64, ws + W_LI, 2048, n0, 0, nullptr)
        TR_JOB(p.in[9], 64, D, 64, ws + W_LI, 2048, n0, 1024, p.in[5] + 3 * D)
        TR_JOB(p.in[9] + 65536, 64, D, 64, ws + W_LI, 2048, 64 + n0, 0, nullptr)
        TR_JOB(p.in[9] + 65536, 64, D, 64, ws + W_LI, 2048, 64 + n0, 1024, p.in[5] + 3 * D)
        TR_JOB(p.in[12], 64, D, 64, ws + W_LI, 2048, 128 + n0, 0, nullptr)
        TR_JOB(p.in[12], 64, D, 64, ws + W_LI, 2048, 128 + n0, 1024, p.in[5] + 4 * D)
        TR_JOB(p.in[12] + 65536, 64, D, 64, ws + W_LI, 2048, 192 + n0, 0, nullptr)
        TR_JOB(p.in[12] + 65536, 64, D, 64, ws + W_LI, 2048, 192 + n0, 1024, p.in[5] + 4 * D)
        TR_JOB(p.in[14], 128, D, 128, ws + W_LI, 2048, 256 + n0, 0, nullptr)
        TR_JOB(p.in[14], 128, D, 128, ws + W_LI, 2048, 256 + n0, 1024, p.in[5] + 5 * D)
        TR_JOB(p.in[15], D, 128, D, ws + W_LO, 256, n0, 0, nullptr)
    }
#undef TR_JOB
    { const u32x4 z = {0u, 0u, 0u, 0u};
      u32x4* zl = (u32x4*)(ws + W_LI + (size_t)384 * 2048 * 2);
      for (int i = gt; i < 128 * 2048 * 2 / 16; i += NGT) zl[i] = z;
      for (int i = gt; i < 1024 * 16; i += NGT) { const int row = i >> 4, c16 = i & 15; *(u32x4*)(ws + W_LO + (size_t)row * 512 + 256 + c16 * 16) = z; } }
    { u16* dc = (u16*)(ws + W_DFTC);
      for (int i = gt; i < 512 * 256 / 8; i += NGT) { const int m = i >> 5, k0 = (i & 31) * 8, f = m >> 1, cs = m & 1; float v[8];
#pragma unroll
          for (int e = 0; e < 8; ++e) { const float a = (float)((f * (k0 + e)) & 255) * (1.0f / 128.0f); v[e] = cs ? sinpif(a) : cospif(a); }
          u32x4 o; o.x = cvt_pk_bf16(v[0], v[1]); o.y = cvt_pk_bf16(v[2], v[3]); o.z = cvt_pk_bf16(v[4], v[5]); o.w = cvt_pk_bf16(v[6], v[7]);
          *(u32x4*)(dc + (size_t)m * 256 + k0) = o; }
      u16* wsq = (u16*)(ws + W_WS);
      const float alpha = 0.0013810679f;
      for (int i = gt; i < 2048 * 2048 / 8; i += NGT) { const int s = i >> 8, k0 = (i & 255) * 8, cs = k0 >> 10, sp0 = k0 & 1023; float v[8];
#pragma unroll
          for (int e = 0; e < 8; ++e) { const float a = (float)((s * (sp0 + e)) & 2047) * (1.0f / 1024.0f); v[e] = cs ? -alpha * sinpif(a) : alpha * cospif(a); }
          u32x4 o; o.x = cvt_pk_bf16(v[0], v[1]); o.y = cvt_pk_bf16(v[2], v[3]); o.z = cvt_pk_bf16(v[4], v[5]); o.w = cvt_pk_bf16(v[6], v[7]);
          *(u32x4*)(wsq + (size_t)s * 2048 + k0) = o; } }
    phase_rmsnorm_bf16(p.in[0], p.in[1], (u16*)(ws + A_H0), D);
}

__device__ __forceinline__ void phase_shift(const Params& p) {
    const int lane = threadIdx.x & 63, gw = blockIdx.x * 8 + (threadIdx.x >> 6), NGW = gridDim.x * 8;
    const u16* x = (const u16*)p.out; const float* g = p.in[1] + D; const float* mu = p.in[5];
    u16* hx = (u16*)(p.ws + A_HX); u16* xs = (u16*)(p.ws + A_XS);
    f32x4 gv[4], mr[4], mk[4], mv[4];
#pragma unroll
    for (int j = 0; j < 4; ++j) { gv[j] = ((const f32x4*)g)[VIDX(lane, j)]; mr[j] = ((const f32x4*)mu)[VIDX(lane, j)]; mk[j] = ((const f32x4*)(mu + D))[VIDX(lane, j)]; mv[j] = ((const f32x4*)(mu + 2 * D))[VIDX(lane, j)]; }
    const f32x4 z4 = {0.f, 0.f, 0.f, 0.f};
    for (int grp = gw; grp < M / 16; grp += NGW) {
        const int t0 = grp * 16, s0 = t0 & (SEQ - 1);
        f32x4 hp[4], hc[4], hn[4];
        if (s0 > 0) rms_row_b(x + (size_t)(t0 - 1) * D, gv, hp, lane); else { hp[0] = z4; hp[1] = z4; hp[2] = z4; hp[3] = z4; }
        rms_row_b(x + (size_t)t0 * D, gv, hc, lane);
        for (int i = 0; i < 16; ++i) {
            const int t = t0 + i;
            if (s0 + i + 1 < SEQ) rms_row_b(x + (size_t)(t + 1) * D, gv, hn, lane); else { hn[0] = z4; hn[1] = z4; hn[2] = z4; hn[3] = z4; }
            f32x4 xx[4], o[4];
#pragma unroll
            for (int j = 0; j < 4; ++j) xx[j] = (hp[j] + hn[j]) * 0.5f - hc[j];
            store_row_bf16(hx + (size_t)t * 2048, hc, lane);
            store_row_bf16(hx + (size_t)t * 2048 + D, xx, lane);
#pragma unroll
            for (int j = 0; j < 4; ++j) o[j] = hc[j] + xx[j] * mr[j];
            store_row_bf16(xs + (size_t)t * D, o, lane);
#pragma unroll
            for (int j = 0; j < 4; ++j) o[j] = hc[j] + xx[j] * mk[j];
            store_row_bf16(xs + (size_t)M * D + (size_t)t * D, o, lane);
#pragma unroll
            for (int j = 0; j < 4; ++j) o[j] = hc[j] + xx[j] * mv[j];
            store_row_bf16(xs + (size_t)2 * M * D + (size_t)t * D, o, lane);
#pragma unroll
            for (int j = 0; j < 4; ++j) { hp[j] = hc[j]; hc[j] = hn[j]; }
        }
    }
}

__device__ __forceinline__ void phase_postscan(const Params& p) {
    const int tid = threadIdx.x, cg8 = tid & 127;
    const h16* yf = (const h16*)(p.ws + A_YF); const h16* yb = (const h16*)(p.ws + A_YB); const h16* vv = (const h16*)(p.ws + A_V);
    const u16* gg = (const u16*)(p.ws + A_G); const float* bon = (const float*)(p.ws + A_BON); u16* outp = (u16*)(p.ws + A_GATED);
    float lw[8], lb[8];
#pragma unroll
    for (int e = 0; e < 8; ++e) { lw[e] = p.in[19][cg8 * 8 + e]; lb[e] = p.in[20][cg8 * 8 + e]; }
    for (int tok = blockIdx.x * 4 + (tid >> 7); tok < M; tok += gridDim.x * 4) {
        const size_t o = (size_t)tok * D + cg8 * 8;
        const h16x8 a = *(const h16x8*)(yf + o), b = *(const h16x8*)(yb + o), v8 = *(const h16x8*)(vv + o);
        const u32x4 g4 = *(const u32x4*)(gg + o);
        const float bs = bon[(size_t)tok * 16 + (cg8 >> 3)] + bon[(size_t)M * 16 + (size_t)tok * 16 + (cg8 >> 3)];
        float y[8], s = 0.f;
#pragma unroll
        for (int e = 0; e < 8; ++e) { y[e] = (float)a[e] + (float)b[e]; s += y[e]; }
        s += __shfl_xor(s, 1); s += __shfl_xor(s, 2); s += __shfl_xor(s, 4);
        const float mean = s * (1.f / 64.f); float q = 0.f;
#pragma unroll
        for (int e = 0; e < 8; ++e) { y[e] -= mean; q += y[e] * y[e]; }
        q += __shfl_xor(q, 1); q += __shfl_xor(q, 2); q += __shfl_xor(q, 4);
        const float rstd = rsqrtf(q * (1.f / 64.f) + 64e-5f);
        float r[8];
#pragma unroll
        for (int e = 0; e < 8; ++e) { const unsigned gw = (e & 1) ? (g4[e >> 1] >> 16) : (g4[e >> 1] & 0xffffu);
            const float yn = y[e] * rstd * lw[e] + lb[e]; r[e] = (yn + bs * (float)v8[e]) * bf2f(gw); }
        u32x4 w; w.x = cvt_pk_bf16(r[0], r[1]); w.y = cvt_pk_bf16(r[2], r[3]); w.z = cvt_pk_bf16(r[4], r[5]); w.w = cvt_pk_bf16(r[6], r[7]);
        *(u32x4*)(outp + o) = w;
    }
}

constexpr int RP = 144, A3P = 80;
constexpr int CS_KH = 0, CS_RH = 2304, CS_KC = 4608, CS_BC = 6912, CS_GL = 9216, CS_BN = 9472, CS_BYTES = 9728;
static_assert(12 * CS_BYTES + 2560 <= 131072, "scan LDS map");
typedef _Float16 h16x4 __attribute__((ext_vector_type(4)));
typedef short s16x4 __attribute__((ext_vector_type(4)));

__device__ __forceinline__ bf16x8 mk8(u32x2 lo, u32x2 hi) { const u32x4 t = {lo.x, lo.y, hi.x, hi.y}; return __builtin_bit_cast(bf16x8, t); }
__device__ __forceinline__ u32x2 pk4(float a, float b, float c, float d) { u32x2 r; r.x = cvt_pk_bf16(a, b); r.y = cvt_pk_bf16(c, d); return r; }
__device__ __forceinline__ bf16x8 lo8(const f32x4 x) { const u32x2 z2 = {0u, 0u}; return mk8(pk4(x[0], x[1], x[2], x[3]), z2); }
#define MFMA16(a, b, c) __builtin_amdgcn_mfma_f32_16x16x32_bf16(a, b, c, 0, 0, 0)
__device__ __forceinline__ float rowsum4(float x) {
    const unsigned u = __float_as_uint(x);
    auto p = __builtin_amdgcn_permlane32_swap(u, u, false, false);
    const float a = __uint_as_float(p[0]) + __uint_as_float(p[1]);
    const unsigned v = __float_as_uint(a);
    auto q = __builtin_amdgcn_permlane16_swap(v, v, false, false);
    return __uint_as_float(q[0]) + __uint_as_float(q[1]);
}
template <int CTRL> __device__ __forceinline__ float dpp0(float x) {
    return __uint_as_float((unsigned)__builtin_amdgcn_update_dpp(0, (int)__float_as_uint(x), CTRL, 0xf, 0xf, true));
}

__device__ __forceinline__ void phase_scan(const Params& p, LAS unsigned char* lds) {
    const int tid = threadIdx.x, lane = tid & 63, wave = tid >> 6;
    const int d = wave >> 2, w = wave & 3, q = lane >> 4, n = lane & 15;
    const h16* Rg = (const h16*)(p.ws + A_R); const h16* Kg = (const h16*)(p.ws + A_K); const h16* Vg = (const h16*)(p.ws + A_V);
    const u16* mid = (const u16*)(p.ws + A_MID);
    h16* Yd = (h16*)(p.ws + (d ? A_YB : A_YF));
    float* bon = (float*)(p.ws + A_BON);
    {
        const int pair = blockIdx.x; const int b = pair >> 4, h = pair & 15, hc = h * 64;
        const size_t tokb = (size_t)b * SEQ;
        const int c4 = 16 * w + 4 * q;
        h16x2 kkslab[8];
#pragma unroll
        for (int e = 0; e < 8; ++e) kkslab[e] = (h16x2){(h16)p.in[16][hc + 16 * q + 2 * e], (h16)p.in[16][hc + 16 * q + 2 * e + 1]};
        LAS f32x4* cst = (LAS f32x4*)(lds + 12 * CS_BYTES + (wave * 4 + q) * 80);
        if (n == 0) {
            cst[0] = *(const f32x4*)(p.in[16] + hc + c4); cst[1] = *(const f32x4*)(p.in[8] + d * D + hc + c4); cst[2] = *(const f32x4*)(p.in[11] + d * D + hc + c4);
            cst[3] = *(const f32x4*)(p.in[17] + hc + c4); cst[4] = *(const f32x4*)(p.in[18] + hc + c4); }
        __syncthreads();
        bf16x8 Bw[2], Ba[2];
#pragma unroll
        for (int ks = 0; ks < 2; ++ks) { float tw[8], ta[8];
#pragma unroll
            for (int j = 0; j < 8; ++j) { const int kr = 32 * ks + 8 * q + j; tw[j] = p.in[10][(size_t)d * 65536 + (size_t)kr * D + hc + 16 * w + n]; ta[j] = p.in[13][(size_t)d * 65536 + (size_t)kr * D + hc + 16 * w + n]; }
            Bw[ks] = mk8(pk4(tw[0], tw[1], tw[2], tw[3]), pk4(tw[4], tw[5], tw[6], tw[7])); Ba[ks] = mk8(pk4(ta[0], ta[1], ta[2], ta[3]), pk4(ta[4], ta[5], ta[6], ta[7])); }
        f32x4 S[4];
#pragma unroll
        for (int rb = 0; rb < 4; ++rb) S[rb] = (f32x4){0.f, 0.f, 0.f, 0.f};
        struct Raw { h16x8 ks0, ks1; h16x4 k4, r4; u32x4 A0, A1, A2, A3; h16 v0, v1, v2, v3; };
        Raw rawX, rawY;
        auto tokbase = [&](int ci) -> int { return d ? (SEQ - 16 - 16 * ci) : 16 * ci; };
        auto load_raw = [&](int ci, Raw& rw) {
            const size_t tok = tokb + tokbase(ci) + (d ? 15 - n : n);
            rw.ks0 = *(const h16x8*)(Kg + tok * D + hc + 16 * q); rw.ks1 = *(const h16x8*)(Kg + tok * D + hc + 16 * q + 8);
            rw.k4 = *(const h16x4*)(Kg + tok * D + hc + c4); rw.r4 = *(const h16x4*)(Rg + tok * D + hc + c4);
            const size_t mo = tok * 512 + d * 64 + 8 * q;
            rw.A0 = *(const u32x4*)(mid + mo); rw.A1 = *(const u32x4*)(mid + mo + 32); rw.A2 = *(const u32x4*)(mid + mo + 128); rw.A3 = *(const u32x4*)(mid + mo + 160);
            const h16* vb = Vg + (tokb + tokbase(ci)) * D + hc + 16 * w + n; const int j0 = 4 * q;
            rw.v0 = vb[(size_t)(d ? 15 - j0 : j0) * D]; rw.v1 = vb[(size_t)(d ? 14 - j0 : j0 + 1) * D]; rw.v2 = vb[(size_t)(d ? 13 - j0 : j0 + 2) * D]; rw.v3 = vb[(size_t)(d ? 12 - j0 : j0 + 3) * D];
        };
        auto prep = [&](int slot, const Raw& rw) -> u32x2 {
            LAS unsigned char* cs = lds + (slot * 2 + d) * CS_BYTES;
            const u32x2 Bv = pk4((float)rw.v0, (float)rw.v1, (float)rw.v2, (float)rw.v3);
            float ss = 0.f;
            { const h16x2* k2a = (const h16x2*)&rw.ks0; const h16x2* k2b = (const h16x2*)&rw.ks1;
#pragma unroll
              for (int e = 0; e < 4; ++e) { const h16x2 pa = k2a[e] * kkslab[e], pb = k2b[e] * kkslab[4 + e]; ss = __builtin_amdgcn_fdot2(pa, pa, ss, false); ss = __builtin_amdgcn_fdot2(pb, pb, ss, false); } }
            ss = rowsum4(ss);
            const float rn = rsqrtf(fmaxf(ss, 1e-24f));
            f32x4 Dw = {0.f, 0.f, 0.f, 0.f}, Da = {0.f, 0.f, 0.f, 0.f};
            Dw = MFMA16(Bw[0], __builtin_bit_cast(bf16x8, rw.A0), Dw); Dw = MFMA16(Bw[1], __builtin_bit_cast(bf16x8, rw.A1), Dw);
            Da = MFMA16(Ba[0], __builtin_bit_cast(bf16x8, rw.A2), Da); Da = MFMA16(Ba[1], __builtin_bit_cast(bf16x8, rw.A3), Da);
            const f32x4 kk4c = cst[0], w0c = cst[1], a0c = cst[2], kac = cst[3], rkc = cst[4];
            float G[4], Gp[4], GLv[4], kh[4], rh[4], kc[4], bc[4], bsum = 0.f;
#pragma unroll
            for (int i = 0; i < 4; ++i) {
                const float l2 = -0.87503730f * fsigmoid(w0c[i] + Dw[i]), av = fsigmoid(a0c[i] + Da[i]);
                float ps = l2;
                ps += dpp0<0x111>(ps); ps += dpp0<0x112>(ps); ps += dpp0<0x114>(ps); ps += dpp0<0x118>(ps);
                const float g = __builtin_amdgcn_exp2f(ps), ig = __builtin_amdgcn_exp2f(-ps);
                G[i] = g; Gp[i] = __builtin_amdgcn_exp2f(ps - l2); GLv[i] = __builtin_amdgcn_exp2f(dpp0<0x15F>(ps));
                const float kf = (float)rw.k4[i], rf = (float)rw.r4[i], kkv = kf * kk4c[i] * rn;
                const float bb = kkv * av, kd = kf * (1.0f + (av - 1.0f) * kac[i]);
                kh[i] = kkv * Gp[i]; rh[i] = rf * g; kc[i] = kd * ig; bc[i] = bb * ig;
                bsum += rf * kd * rkc[i]; }
            const int ro = n * RP + c4 * 2;
            *(LAS u32x2*)(cs + CS_KH + ro) = pk4(kh[0], kh[1], kh[2], kh[3]); *(LAS u32x2*)(cs + CS_RH + ro) = pk4(rh[0], rh[1], rh[2], rh[3]);
            *(LAS u32x2*)(cs + CS_KC + ro) = pk4(kc[0], kc[1], kc[2], kc[3]); *(LAS u32x2*)(cs + CS_BC + ro) = pk4(bc[0], bc[1], bc[2], bc[3]);
            if (n == 0) *(LAS f32x4*)(cs + CS_GL + c4 * 4) = (f32x4){GLv[0], GLv[1], GLv[2], GLv[3]};
            bsum = rowsum4(bsum);
            if (q == 0) *(LAS float*)(cs + CS_BN + (w * 16 + n) * 4) = bsum;
            return Bv;
        };
        auto gramT = [&](int slot, int gd, int part, LAS unsigned char* gt) {
            const LAS unsigned char* cs = lds + (slot * 2 + gd) * CS_BYTES;
            const f32x4 z4 = {0.f, 0.f, 0.f, 0.f}; const u32x2 z2 = {0u, 0u};
            bf16x8 fBC[2], fKH[2];
#pragma unroll
            for (int s2 = 0; s2 < 2; ++s2) { const int o = n * RP + 64 * s2 + 16 * q; fBC[s2] = *(const LAS bf16x8*)(cs + CS_BC + o); fKH[s2] = *(const LAS bf16x8*)(cs + CS_KH + o); }
            if (part == 0) {
                bf16x8 fKC[2], fRH[2];
#pragma unroll
                for (int s2 = 0; s2 < 2; ++s2) { const int o = n * RP + 64 * s2 + 16 * q; fKC[s2] = *(const LAS bf16x8*)(cs + CS_KC + o); fRH[s2] = *(const LAS bf16x8*)(cs + CS_RH + o); }
                f32x4 D1 = z4, D3 = z4, D4 = z4;
#pragma unroll
                for (int s2 = 0; s2 < 2; ++s2) { D1 = MFMA16(fKC[s2], fKH[s2], D1); D3 = MFMA16(fKC[s2], fRH[s2], D3); D4 = MFMA16(fBC[s2], fRH[s2], D4); }
                f32x4 a1, a3, a4;
#pragma unroll
                for (int i = 0; i < 4; ++i) { const int sidx = 4 * q + i; const bool lt = sidx < n, le = sidx <= n; a1[i] = lt ? D1[i] : 0.f; a3[i] = le ? D3[i] : 0.f; a4[i] = le ? D4[i] : 0.f; }
                *(LAS bf16x8*)(gt + lane * 16) = mk8(pk4(a1[0], a1[1], a1[2], a1[3]), z2);
                *(LAS bf16x8*)(gt + 1024 + lane * 16) = mk8(pk4(a3[0], a3[1], a3[2], a3[3]), pk4(a4[0], a4[1], a4[2], a4[3]));
            } else {
                f32x4 D2 = z4, D5 = z4;
#pragma unroll
                for (int s2 = 0; s2 < 2; ++s2) { D2 = MFMA16(fBC[s2], fKH[s2], D2); D5 = MFMA16(fKH[s2], fBC[s2], D5); }
                f32x4 Zd, Nd, R, Id;
#pragma unroll
                for (int i = 0; i < 4; ++i) { const int sidx = 4 * q + i; Zd[i] = (sidx < n) ? -D2[i] : 0.f; Nd[i] = (sidx > n) ? -D5[i] : 0.f; Id[i] = (sidx == n) ? 1.f : 0.f; }
                const bf16x8 oN = lo8(Nd), oZ = lo8(Zd);
                const f32x4 Z2 = MFMA16(oN, oZ, z4), N2 = MFMA16(oZ, oN, z4);
                const bf16x8 oN2 = lo8(N2), oZ2 = lo8(Z2);
                const f32x4 Z4 = MFMA16(oN2, oZ2, z4), N4 = MFMA16(oZ2, oN2, z4);
                const bf16x8 oN4 = lo8(N4);
                const f32x4 N8 = MFMA16(lo8(Z4), oN4, z4);
                R = Zd + Id;
                R = MFMA16(oN2, lo8(R), R); R = MFMA16(oN4, lo8(R), R); R = MFMA16(lo8(N8), lo8(R), R);
                *(LAS bf16x8*)(gt + 2048 + lane * 16) = lo8(R - Id);
            }
        };
        h16* const ybase = Yd + tokb * D + hc + 16 * w + n;
        int yro[4];
#pragma unroll
        for (int i = 0; i < 4; ++i) yro[i] = (d ? 15 - (4 * q + i) : 4 * q + i) * D;
        auto consume = [&](int ci, int slot, const u32x2 Bv, const LAS unsigned char* gt) {
            const LAS unsigned char* cs = lds + (slot * 2 + d) * CS_BYTES;
            const bf16x8 A1e = *(const LAS bf16x8*)(gt + lane * 16), A4e = *(const LAS bf16x8*)(gt + 1024 + lane * 16), TXe = *(const LAS bf16x8*)(gt + 2048 + lane * 16);
            const f32x4 z4 = {0.f, 0.f, 0.f, 0.f}; const u32x2 z2 = {0u, 0u};
            bf16x8 Bs[2], AK[2], AR[2];
#pragma unroll
            for (int s2 = 0; s2 < 2; ++s2) { Bs[s2] = mk8(pk4(S[2 * s2][0], S[2 * s2][1], S[2 * s2][2], S[2 * s2][3]), pk4(S[2 * s2 + 1][0], S[2 * s2 + 1][1], S[2 * s2 + 1][2], S[2 * s2 + 1][3]));
                const int o = n * RP + (32 * s2 + 4 * q) * 2;
                AK[s2] = mk8(*(const LAS u32x2*)(cs + CS_KH + o), *(const LAS u32x2*)(cs + CS_KH + o + 32)); AR[s2] = mk8(*(const LAS u32x2*)(cs + CS_RH + o), *(const LAS u32x2*)(cs + CS_RH + o + 32)); }
            f32x4 X = z4;
            X = MFMA16(AK[0], Bs[0], X); X = MFMA16(AK[1], Bs[1], X); X = MFMA16(A1e, mk8(Bv, z2), X);
            const f32x4 U = MFMA16(TXe, lo8(X), X);
            const bf16x8 Bvu = mk8(Bv, pk4(-U[0], -U[1], -U[2], -U[3]));
            f32x4 Y = z4;
            Y = MFMA16(AR[0], Bs[0], Y); Y = MFMA16(AR[1], Bs[1], Y); Y = MFMA16(A4e, Bvu, Y);
            const int tro = (4 * q + (n >> 2)) * RP + (n & 3) * 8;
#pragma unroll
            for (int rb = 0; rb < 4; ++rb) { const f32x4 g4 = *(const LAS f32x4*)(cs + CS_GL + (16 * rb + 4 * q) * 4);
                const s16x4 kT = __builtin_amdgcn_ds_read_tr16_b64_v4i16((LAS s16x4*)(cs + CS_KC + tro + 32 * rb)), bT = __builtin_amdgcn_ds_read_tr16_b64_v4i16((LAS s16x4*)(cs + CS_BC + tro + 32 * rb));
                const bf16x8 A3e = mk8(__builtin_bit_cast(u32x2, kT), __builtin_bit_cast(u32x2, bT));
                S[rb] = MFMA16(A3e, Bvu, S[rb]) * g4; }
            h16* yp = ybase + (size_t)tokbase(ci) * D;
#pragma unroll
            for (int i = 0; i < 4; ++i) yp[yro[i]] = (h16)Y[i];
        };
        LAS unsigned char* const gtb = lds + GT_OFF;
        constexpr int NIT = SEQ / 32;
        auto Gst = [&](int j) { gramT((j % 3) * 2 + (w & 1), w >> 1, d, gtb + ((j & 1) * 4 + (w & 1) * 2 + (w >> 1)) * 3072);
            if (w == 0 && lane < 32) { const int sub = lane >> 4, tt = lane & 15; const LAS float* bn = (const LAS float*)(lds + (((j % 3) * 2 + sub) * 2 + d) * CS_BYTES + CS_BN);
                bon[(size_t)d * M * 16 + (tokb + tokbase(2 * j + sub) + (d ? 15 - tt : tt)) * 16 + h] = (bn[tt] + bn[16 + tt]) + (bn[32 + tt] + bn[48 + tt]); } };
        u32x2 BvAX, BvAY, BvBX, BvBY, BvCX = {0u, 0u}, BvCY = {0u, 0u};
        load_raw(0, rawX); load_raw(1, rawY);
        BvAX = prep(0, rawX); BvAY = prep(1, rawY);
        load_raw(2, rawX); load_raw(3, rawY);
        __syncthreads();
        BvBX = prep(2, rawX); BvBY = prep(3, rawY);
        Gst(0);
        load_raw(4, rawX); load_raw(5, rawY);
        __syncthreads();
        for (int k = 0; k < NIT; ++k) {
            if (k + 2 < NIT) { const int sl = ((k + 2) % 3) * 2; BvCX = prep(sl, rawX); BvCY = prep(sl + 1, rawY); }
            if (k + 1 < NIT) Gst(k + 1);
            { const int sl = (k % 3) * 2; consume(2 * k, sl, BvAX, gtb + ((k & 1) * 4 + 0 * 2 + d) * 3072); consume(2 * k + 1, sl + 1, BvAY, gtb + ((k & 1) * 4 + 1 * 2 + d) * 3072); }
            if (k + 3 < NIT) { load_raw(2 * (k + 3), rawX); load_raw(2 * (k + 3) + 1, rawY); }
            BvAX = BvBX; BvAY = BvBY; BvBX = BvCX; BvBY = BvCY;
            __syncthreads();
        }
        __syncthreads();
    }
}

#define XB_TMO      128
#define XB_XCNT(j)  (256  + 64 * (j))
#define XB_XSUB(j)  (1280 + 64 * (j))
#define XB_XGEN(j)  (2304 + 64 * (j))
#define XB_TOP      3328
#define XB_TOPGEN   3392
#define XCD_BAR_WORDS 3456
#define XB_SPIN_CAP (1u << 22)
__device__ __forceinline__ unsigned xb_ld(unsigned* p)              { return __hip_atomic_load(p, __ATOMIC_RELAXED, __HIP_MEMORY_SCOPE_AGENT); }
__device__ __forceinline__ unsigned xb_add(unsigned* p, unsigned v) { return __hip_atomic_fetch_add(p, v, __ATOMIC_RELAXED, __HIP_MEMORY_SCOPE_AGENT); }
__device__ __forceinline__ unsigned xb_xcc_id() { return (unsigned)__builtin_amdgcn_s_getreg((3 << 11) | 20) & 0xFu; }
#define XB_SPIN(cond, bar) do { unsigned _sp = 0; while (cond) { __builtin_amdgcn_s_sleep(1); \
    if ((++_sp & 255u) == 0u) { if (xb_ld(&(bar)[XB_TMO])) break; if (_sp > XB_SPIN_CAP) { atomicAdd(&(bar)[XB_TMO], 1u); break; } } } } while (0)
struct XcdBarrier { unsigned* bar; unsigned x; volatile LAS unsigned* st; };
__device__ __forceinline__ XcdBarrier xcd_barrier_post(unsigned* bar, volatile LAS unsigned* st) {
    XcdBarrier b; b.bar = bar; b.x = xb_xcc_id(); b.st = st;
    if (threadIdx.x == 0) (void)xb_add(&bar[XB_XCNT(b.x)], 1u);
    return b;
}
__device__ __forceinline__ void xcd_barrier_complete(unsigned* bar, unsigned x, unsigned& nloc, unsigned& nx) {
    const unsigned G = gridDim.x * gridDim.y * gridDim.z;
    unsigned sum, cnt, mine, sp = 0u;
    for (;;) {
        sum = 0u; cnt = 0u; mine = 0u;
#pragma unroll
        for (unsigned j = 0; j < 16; ++j) { const unsigned c = xb_ld(&bar[XB_XCNT(j)]); sum += c; cnt += (c > 0u) ? 1u : 0u; mine = (j == x) ? c : mine; }
        if (sum == G) break;
        __builtin_amdgcn_s_sleep(1);
        if ((++sp & 255u) == 0u) { if (xb_ld(&bar[XB_TMO])) break; if (sp > XB_SPIN_CAP) { atomicAdd(&bar[XB_TMO], 1u); break; } }
    }
    nloc = mine > 0u ? mine : 1u; nx = cnt > 0u ? cnt : 1u;
}
__device__ __forceinline__ void xcd_barrier(const XcdBarrier& b) {
    asm volatile("s_waitcnt vmcnt(0)" ::: "memory");
    __syncthreads();
    if (threadIdx.x == 0) {
        unsigned* bar = b.bar;
        __builtin_amdgcn_s_waitcnt(0);
        unsigned nloc = b.st[0], nx = b.st[1];
        if (nloc == 0u) { xcd_barrier_complete(bar, b.x, nloc, nx); b.st[0] = nloc; b.st[1] = nx; }
        const unsigned old = xb_add(&bar[XB_XSUB(b.x)], 1u);
        const unsigned gen = old / nloc;
        if (old + 1u == (gen + 1u) * nloc) {
            __builtin_amdgcn_fence(__ATOMIC_RELEASE, "agent");
            asm volatile("s_waitcnt vmcnt(0)" ::: "memory");
            const unsigned og = xb_add(&bar[XB_TOP], 1u);
            const unsigned tg = og / nx;
            if (og + 1u == (tg + 1u) * nx) xb_add(&bar[XB_TOPGEN], 1u);
            else XB_SPIN(xb_ld(&bar[XB_TOPGEN]) == tg, bar);
            __builtin_amdgcn_fence(__ATOMIC_ACQUIRE, "agent");
            xb_add(&bar[XB_XGEN(b.x)], 1u);
            asm volatile("s_waitcnt vmcnt(0)" ::: "memory");
        } else {
            XB_SPIN(xb_ld(&bar[XB_XGEN(b.x)]) == gen, bar);
            __builtin_amdgcn_fence(__ATOMIC_ACQUIRE, "agent");
            asm volatile("s_waitcnt vmcnt(0)" ::: "memory");
        }
    }
    __syncthreads();
}

__device__ __forceinline__ void set_sched(pg8::Sched& S, const void* A0, const void* B0, int lda, int ldb, int K, int nM, int nN, int nB, int nB2, int aGrp,
                                          long aM, long aG, long aB1, long aB2, long bN, long bB1, long bB2) {
    S.A0 = (const char*)A0; S.B0 = (const char*)B0; S.lda = lda; S.ldb = ldb; S.K = K; S.nM = nM; S.nN = nN; S.nB = nB; S.nB2 = nB2; S.aGrp = aGrp;
    S.aM = aM; S.aG = aG; S.aB1 = aB1; S.aB2 = aB2; S.bN = bN; S.bB1 = bB1; S.bB2 = bB2; S.G = gridDim.x; S.c = blockIdx.x; S.mirTop = 0;
}

__global__ void __launch_bounds__(512, 2) mega(Params p) {
    extern __shared__ __attribute__((aligned(16))) unsigned char lds_dyn[];
    LAS unsigned char* lds = (LAS unsigned char*)lds_dyn;
    unsigned char* ws = p.ws;
    volatile LAS unsigned* xst = (volatile LAS unsigned*)(lds + 131072);
    if (threadIdx.x == 0) { xst[0] = 0u; xst[1] = 0u; }
    __syncthreads();
    XcdBarrier xb; xb.bar = (unsigned*)(ws + W_CTL); xb.x = 0; xb.st = xst;
    if (p.coop) xb = xcd_barrier_post((unsigned*)(ws + W_CTL), xst);
    if (p.coop == 2) cg::this_grid().sync();
#ifndef PROBE_MASK
#define PROBE_MASK 0
#endif
#define IN(ph) (p.ph_lo <= (ph) && (ph) < p.ph_hi)
#define REP(ph) for (int rep_ = 0; rep_ < (((PROBE_MASK >> (ph)) & 1) ? 2 : 1); ++rep_)
#define SEAM(ph) do { if (p.coop && (ph) + 1 < p.ph_hi) xcd_barrier(xb); else __syncthreads(); } while (0)
#define BIG (1 << 30)
    if (IN(0)) REP(0) { phase_prep(p, lds); SEAM(0); }
    if (IN(1)) REP(1) {
        pg8::Sched S; set_sched(S, ws + W_DFTC, ws + A_H0, 256, D, 256, 2, 8, 64, 4, BIG, 256L * 256 * 2, 0, 0, 0, 128L * D * 2, (long)SEQ * D * 2, 512);
        S.mirTop = (long)SEQ * D * 2;
        pg8::EpiFold E; E.O = (u16*)(ws + A_YT);
        pg8::gemm_phase<pg8::EpiFold, true>(lds, S, E);
        { const u16* h0 = (const u16*)(ws + A_H0); const u16* dc = (const u16*)(ws + W_DFTC); float* corr = (float*)(ws + A_CORR);
          for (int i = blockIdx.x * 512 + threadIdx.x; i < 16 * 1024; i += gridDim.x * 512) { const int b = i >> 10, np = i & 1023, g = np >> 8, f = np & 255;
              const u32x4* hp = (const u32x4*)(h0 + ((size_t)b * SEQ + 1024) * D + 256 * g); const u32x4* cp = (const u32x4*)(dc + (size_t)(2 * f) * 256); float a = 0.f;
              for (int k8 = 0; k8 < 32; ++k8) { const u32x4 hv = hp[k8], cv = cp[k8];
#pragma unroll
                  for (int e = 0; e < 4; ++e) a += bf2f(hv[e] & 0xffffu) * bf2f(cv[e] & 0xffffu) + bf2f(hv[e] >> 16) * bf2f(cv[e] >> 16); }
              corr[i] = 0.0013810679f * a; } }
        SEAM(1); }
    if (IN(2)) REP(2) {
        pg8::Sched S; set_sched(S, ws + W_WS, ws + A_YT, 2048, 2048, 2048, 8, 4, 16, 1, BIG, 256L * 2048 * 2, 0, 0, 0, 256L * 2048 * 2, 1024L * 2048 * 2, 0);
        pg8::Epi16 E; E.O0 = (u16*)(ws + A_F); E.O1 = nullptr; E.O2 = nullptr; E.ldc = D; E.grp = 4; E.mode = 3; E.bstride = (long)SEQ * D; E.corr = (const float*)(ws + A_CORR);
        pg8::gemm_phase<pg8::Epi16>(lds, S, E); SEAM(2); }
    if (IN(3)) REP(3) {
        pg8::Sched S; set_sched(S, ws + A_F, ws + W_WOUT, D, D, D, 128, 4, 1, 1, BIG, 256L * D * 2, 0, 0, 0, 256L * D * 2, 0, 0);
        pg8::EpiRes<true> E; E.out = (u16*)p.out; E.res = p.in[0];
        pg8::gemm_phase<pg8::EpiRes<true>>(lds, S, E); SEAM(3); }
    if (IN(4)) REP(4) { phase_rmsnorm_b2b((const u16*)p.out, p.in[2], (u16*)(ws + A_H0)); SEAM(4); }
    if (IN(5)) REP(5) {
        pg8::Sched S; set_sched(S, ws + A_H0, ws + W_GU0, D, D, D, 128, 22, 1, 1, BIG, 256L * D * 2, 0, 0, 0, 256L * D * 2, 0, 0);
        pg8::EpiGLU E; E.O = (u16*)(ws + A_ACT0);
        pg8::gemm_phase<pg8::EpiGLU>(lds, S, E); SEAM(5); }
    if (IN(6)) REP(6) {
        pg8::Sched S; set_sched(S, ws + A_ACT0, ws + W_D0, FF, FF, FF, 128, 4, 1, 1, BIG, 256L * FF * 2, 0, 0, 0, 256L * FF * 2, 0, 0);
        pg8::EpiRes<false> E; E.out = (u16*)p.out; E.res = p.out;
        pg8::gemm_phase<pg8::EpiRes<false>>(lds, S, E); SEAM(6); }
    if (IN(7)) REP(7) { phase_shift(p); SEAM(7); }
    if (IN(8)) REP(8) {
        pg8::Sched S; set_sched(S, ws + A_HX, ws + W_LI, 2048, 2048, 2048, 128, 2, 1, 1, BIG, 256L * 2048 * 2, 0, 0, 0, 256L * 2048 * 2, 0, 0);
        pg8::Epi16 E; E.O0 = (u16*)(ws + A_MID); E.O1 = nullptr; E.O2 = nullptr; E.ldc = 512; E.grp = 2; E.mode = 2; E.bstride = 0; E.corr = nullptr;
        pg8::gemm_phase<pg8::Epi16>(lds, S, E); SEAM(8); }
    if (IN(9)) REP(9) {
        pg8::Sched S; set_sched(S, ws + A_XS, ws + W_RKV, D, D, D, 128, 12, 1, 1, 4, 256L * D * 2, (long)M * D * 2, 0, 0, 256L * D * 2, 0, 0);
        pg8::Epi16 E; E.O0 = (u16*)(ws + A_R); E.O1 = (u16*)(ws + A_K); E.O2 = (u16*)(ws + A_V); E.ldc = D; E.grp = 4; E.mode = 1; E.bstride = 0; E.corr = nullptr;
        pg8::gemm_phase<pg8::Epi16>(lds, S, E); SEAM(9); }
    if (IN(10)) REP(10) {
        pg8::Sched S; set_sched(S, ws + A_MID + 512, ws + W_LO, 512, 256, 256, 128, 4, 1, 1, BIG, 256L * 512 * 2, 0, 0, 0, 256L * 256 * 2, 0, 0);
        pg8::Epi16 E; E.O0 = (u16*)(ws + A_G); E.O1 = nullptr; E.O2 = nullptr; E.ldc = D; E.grp = 4; E.mode = 0; E.bstride = 0; E.corr = nullptr;
        pg8::gemm_phase<pg8::Epi16>(lds, S, E); __syncthreads(); }
    if (IN(11)) REP(11) { phase_scan(p, lds); SEAM(11); }
    if (IN(12)) REP(12) { phase_postscan(p); SEAM(12); }
    if (IN(13)) REP(13) {
        pg8::Sched S; set_sched(S, ws + A_GATED, ws + W_WO, D, D, D, 128, 4, 1, 1, BIG, 256L * D * 2, 0, 0, 0, 256L * D * 2, 0, 0);
        pg8::EpiRes<false> E; E.out = (u16*)p.out; E.res = p.out;
        pg8::gemm_phase<pg8::EpiRes<false>>(lds, S, E); SEAM(13); }
    if (IN(14)) REP(14) { phase_rmsnorm_b2b((const u16*)p.out, p.in[2] + D, (u16*)(ws + A_H1)); SEAM(14); }
    if (IN(15)) REP(15) {
        pg8::Sched S; set_sched(S, ws + A_H1, ws + W_GU1, D, D, D, 128, 22, 1, 1, BIG, 256L * D * 2, 0, 0, 0, 256L * D * 2, 0, 0);
        pg8::EpiGLU E; E.O = (u16*)(ws + A_ACT1);
        pg8::gemm_phase<pg8::EpiGLU>(lds, S, E); SEAM(15); }
    if (IN(16)) REP(16) {
        pg8::Sched S; set_sched(S, ws + A_ACT1, ws + W_D1, FF, FF, FF, 128, 4, 1, 1, BIG, 256L * FF * 2, 0, 0, 0, 256L * FF * 2, 0, 0);
        pg8::EpiRes<false> E; E.out = (u16*)(ws + A_XF); E.res = p.out;
        pg8::gemm_phase<pg8::EpiRes<false>>(lds, S, E); SEAM(16); }
    if (IN(17)) REP(17) { phase_rmsnorm_final((const u16*)(ws + A_XF), p.out, p.in[3]); }
#undef IN
#undef SEAM
#undef BIG
}

extern "C" void kernel_launch(void* const* d_in, const int* in_sizes, int n_in, void* d_out, int out_size, void* d_ws, size_t ws_size, hipStream_t stream) {
    static int grid = 0;
    if (grid == 0) {
        if (n_in != 24 || out_size != M * D || ws_size < WS_NEED) { fprintf(stderr, "kernel_launch: unexpected shapes (n_in %d out %d ws %zu)\n", n_in, out_size, ws_size); grid = -1; return; }
        int dev = 0, cus = 0, per_cu = 0;
        hipGetDevice(&dev); hipDeviceGetAttribute(&cus, hipDeviceAttributeMultiprocessorCount, dev);
        if (hipFuncSetAttribute((const void*)mega, hipFuncAttributeMaxDynamicSharedMemorySize, LDS_BYTES) != hipSuccess) { fprintf(stderr, "hipFuncSetAttribute failed\n"); grid = -1; return; }
        hipOccupancyMaxActiveBlocksPerMultiprocessor(&per_cu, (const void*)mega, 512, LDS_BYTES);
        (void)hipGetLastError();
        if (per_cu < 1) per_cu = 1;
        grid = cus;
        if (grid != 256) { fprintf(stderr, "kernel_launch: built for a 256-CU device (scan phase: one (batch, head) pair per workgroup); got %d CUs\n", cus); grid = -1; return; }
    }
    if (grid < 0) return;
    Params p{};
    for (int i = 0; i < 24; ++i) p.in[i] = (const float*)d_in[i];
    p.out = (float*)d_out; p.ws = (unsigned char*)d_ws; p.pad = 0;
#if defined(MK_MULTI)
    p.coop = 0;
    for (int ph = 0; ph < NPHASE; ++ph) { p.ph_lo = ph; p.ph_hi = ph + 1; hipLaunchKernelGGL(mega, dim3(grid), dim3(512), LDS_BYTES, stream, p); }
#else
    if (hipMemsetAsync((unsigned char*)d_ws + W_CTL, 0, XCD_BAR_WORDS * 4, stream) != hipSuccess) { fprintf(stderr, "memset of barrier words failed\n"); return; }
    p.coop = 1; p.ph_lo = 0; p.ph_hi = NPHASE;
    void* args[] = {&p};
    hipError_t e = hipLaunchCooperativeKernel((const void*)mega, dim3(grid), dim3(512), args, LDS_BYTES, stream);
    if (e != hipSuccess) fprintf(stderr, "cooperative launch failed: %s (grid %d)\n", hipGetErrorString(e), grid);
#endif
}
```

```cpp
#include <hip/hip_runtime.h>
#include <hip/hip_cooperative_groups.h>
#include <cstdio>
namespace cg = cooperative_groups;

#define LAS __attribute__((address_space(3)))
typedef unsigned short u16;
typedef short bf16x8 __attribute__((ext_vector_type(8)));
typedef float f32x4 __attribute__((ext_vector_type(4)));
typedef unsigned u32x4 __attribute__((ext_vector_type(4)));
typedef unsigned u32x2 __attribute__((ext_vector_type(2)));
typedef _Float16 h16;
typedef _Float16 h16x2 __attribute__((ext_vector_type(2)));
typedef _Float16 h16x8 __attribute__((ext_vector_type(8)));

constexpr int D = 1024, SEQ = 2048, NB = 16, M = NB * SEQ, FF = 2816;
constexpr size_t MiB = (size_t)1 << 20;
constexpr size_t W_WOUT = 0, W_GU0 = 2 * MiB, W_GU1 = 13 * MiB, W_D0 = 24 * MiB, W_D1 = 24 * MiB + 5632 * 1024, W_RKV = 35 * MiB, W_WO = 41 * MiB,
                 W_LI = 43 * MiB, W_LO = 45 * MiB, W_DFTC = 45 * MiB + 512 * 1024, W_WS = 46 * MiB, W_CTL = 63 * MiB;
constexpr size_t A_H0 = 64 * MiB, A_YT = 128 * MiB, A_F = 256 * MiB, A_ACT0 = 128 * MiB;
constexpr size_t A_HX = 64 * MiB, A_XS = 192 * MiB, A_MID = 384 * MiB, A_R = 64 * MiB, A_K = 128 * MiB, A_V = 416 * MiB, A_YF = 192 * MiB, A_YB = 256 * MiB,
                 A_G = 320 * MiB, A_BON = 480 * MiB, A_GATED = 64 * MiB, A_H1 = 128 * MiB, A_ACT1 = 192 * MiB;
constexpr size_t A_XF = 64 * MiB;
constexpr size_t A_CORR = 484 * MiB;
constexpr size_t WS_NEED = 485 * MiB;
constexpr int GT_OFF = 131072 + 64, LDS_BYTES = GT_OFF + 8 * 3072;
constexpr int NPHASE = 18;

struct Params { const float* in[24]; float* out; unsigned char* ws; int ph_lo, ph_hi, coop, pad; };

typedef __bf16 bf16x2n __attribute__((ext_vector_type(2)));
__device__ __forceinline__ unsigned cvt_pk_bf16(float lo, float hi) { const bf16x2n v = {(__bf16)lo, (__bf16)hi}; return __builtin_bit_cast(unsigned, v); }
__device__ __forceinline__ unsigned cvt_pk_f16(float lo, float hi) { h16x2 p = {(h16)lo, (h16)hi}; return __builtin_bit_cast(unsigned, p); }
__device__ __forceinline__ float bf2f(unsigned b) { return __uint_as_float(b << 16); }
__device__ __forceinline__ float wave_sum(float v) {
#pragma unroll
    for (int o = 1; o < 64; o <<= 1) v += __shfl_xor(v, o);
    return v;
}
__device__ __forceinline__ float fsigmoid(float x) { return __builtin_amdgcn_rcpf(1.0f + __expf(-x)); }
__device__ __forceinline__ float ftanh(float x) { return 1.0f - 2.0f * __builtin_amdgcn_rcpf(1.0f + __expf(2.0f * x)); }

namespace pg8 {
constexpr int BM = 256, BK = 64, HALF = 128, HTB = HALF * BK * 2, NXCD = 8, WGM = 8;
__device__ __forceinline__ int lds_byte(int r, int c) { const int st = (r >> 4) * 2 + (c >> 5), rr = r & 15, cc = c & 31, ob = rr * 64 + cc * 2; return st * 1024 + (ob ^ (((ob >> 9) & 1) << 5)); }
__device__ __forceinline__ void stage_rc(int b, int& R, int& C) { const int st = b / 1024, sb = b % 1024, swz = sb ^ (((sb >> 9) & 1) << 5); R = (st >> 1) * 16 + swz / 64; C = (st & 1) * 32 + (swz % 64) / 2; }
__device__ __forceinline__ int perm32(int rho) { const int n = rho >> 4, i = rho & 15; return 8 * (i >> 2) + 4 * n + (i & 3); }

struct Unit { const char* A; const char* B; const char* B2; int pm, pn, bt; };
struct Sched {
    const char* A0; const char* B0;
    long aM, aG, aB1, aB2, bN, bB1, bB2;
    int nM, nN, nB, nB2, aGrp, lda, ldb, K, G, c;
    long mirTop;
    __device__ bool next(int i, Unit& u) const {
        const int nMt = nM * nB, nwg = nMt * nN;
        const long L = (long)i * G + c; if (L >= nwg) return false;
        int wgid = (int)L; { const int q = nwg / NXCD, r = nwg % NXCD, xcd = wgid % NXCD, off = wgid / NXCD; wgid = (xcd < r ? xcd * (q + 1) : r * (q + 1) + (xcd - r) * q) + off; }
        const int nig = WGM * nN, gid = wgid / nig, fm = gid * WGM, gsz = (nMt - fm) < WGM ? (nMt - fm) : WGM;
        const int PM = fm + ((wgid % nig) % gsz), pn = (wgid % nig) / gsz;
        u.bt = PM / nM; u.pm = PM % nM; u.pn = pn;
        const int b1 = u.bt / nB2, b2 = u.bt % nB2;
        u.A = A0 + (long)b1 * aB1 + (long)b2 * aB2 + (long)u.pm * aM + (long)(pn / aGrp) * aG;
        u.B = B0 + (long)b1 * bB1 + (long)b2 * bB2 + (long)pn * bN;
        u.B2 = B0 + (long)b1 * bB1 + (long)b2 * bB2 + mirTop - (long)pn * bN;
        return true;
    }
};

template <bool RES_F32> struct EpiRes {
    static constexpr bool PERM = true;
    const void* res; u16* out;
    __device__ __forceinline__ void operator()(const f32x4 (&acc)[2][2][4][2], const Unit& u, int wr, int wc, int fr, int fq) const {
        const int row0 = u.pm * BM + wr * 64 + fr, col0 = u.pn * BM + wc * 32 + 8 * fq;
        if (RES_F32) {
#pragma unroll
            for (int ai = 0; ai < 2; ++ai) {
                f32x4 rf[4][2][2];
#pragma unroll
                for (int m = 0; m < 4; ++m)
#pragma unroll
                    for (int bj = 0; bj < 2; ++bj) { const float* rp = (const float*)res + (size_t)(row0 + ai * HALF + m * 16) * D + col0 + bj * HALF; rf[m][bj][0] = *(const f32x4*)rp; rf[m][bj][1] = *(const f32x4*)(rp + 4); }
#pragma unroll
                for (int m = 0; m < 4; ++m)
#pragma unroll
                    for (int bj = 0; bj < 2; ++bj) { const f32x4 v0 = acc[ai][bj][m][0] + rf[m][bj][0], v1 = acc[ai][bj][m][1] + rf[m][bj][1];
                        u32x4 w; w.x = cvt_pk_bf16(v0[0], v0[1]); w.y = cvt_pk_bf16(v0[2], v0[3]); w.z = cvt_pk_bf16(v1[0], v1[1]); w.w = cvt_pk_bf16(v1[2], v1[3]);
                        *(u32x4*)(out + (size_t)(row0 + ai * HALF + m * 16) * D + col0 + bj * HALF) = w; }
            }
        } else {
            u32x4 rb[2][4][2];
#pragma unroll
            for (int ai = 0; ai < 2; ++ai)
#pragma unroll
                for (int m = 0; m < 4; ++m)
#pragma unroll
                    for (int bj = 0; bj < 2; ++bj) rb[ai][m][bj] = *(const u32x4*)((const u16*)res + (size_t)(row0 + ai * HALF + m * 16) * D + col0 + bj * HALF);
#pragma unroll
            for (int ai = 0; ai < 2; ++ai)
#pragma unroll
                for (int m = 0; m < 4; ++m)
#pragma unroll
                    for (int bj = 0; bj < 2; ++bj) { const u32x4 t = rb[ai][m][bj];
                        const f32x4 r0 = {bf2f(t.x & 0xffffu), bf2f(t.x >> 16), bf2f(t.y & 0xffffu), bf2f(t.y >> 16)}, r1 = {bf2f(t.z & 0xffffu), bf2f(t.z >> 16), bf2f(t.w & 0xffffu), bf2f(t.w >> 16)};
                        const f32x4 v0 = acc[ai][bj][m][0] + r0, v1 = acc[ai][bj][m][1] + r1;
                        u32x4 w; w.x = cvt_pk_bf16(v0[0], v0[1]); w.y = cvt_pk_bf16(v0[2], v0[3]); w.z = cvt_pk_bf16(v1[0], v1[1]); w.w = cvt_pk_bf16(v1[2], v1[3]);
                        *(u32x4*)(out + (size_t)(row0 + ai * HALF + m * 16) * D + col0 + bj * HALF) = w; }
        }
    }
};
struct Epi16 {
    static constexpr bool PERM = true;
    u16 *O0, *O1, *O2; int ldc, grp, mode; long bstride; const float* corr;
    __device__ __forceinline__ void operator()(const f32x4 (&acc)[2][2][4][2], const Unit& u, int wr, int wc, int fr, int fq) const {
        const int g = u.pn / grp, colt = (u.pn % grp) * BM;
        u16* base = (g == 0 ? O0 : (g == 1 ? O1 : O2)) + (size_t)u.bt * bstride;
        const int row0 = u.pm * BM + wr * 64 + fr, col0 = colt + wc * 32 + 8 * fq;
        f32x4 cr[2][2] = {};
        if (mode == 3) { const float sg = (fr & 1) ? -1.f : 1.f;
#pragma unroll
            for (int bj = 0; bj < 2; ++bj) { const float* cp = corr + (size_t)u.bt * D + col0 + bj * HALF; cr[bj][0] = *(const f32x4*)cp * sg; cr[bj][1] = *(const f32x4*)(cp + 4) * sg; } }
#pragma unroll
        for (int ai = 0; ai < 2; ++ai)
#pragma unroll
            for (int m = 0; m < 4; ++m) { u16* rowp = base + (size_t)(row0 + ai * HALF + m * 16) * ldc + col0;
#pragma unroll
                for (int bj = 0; bj < 2; ++bj) { f32x4 v0 = acc[ai][bj][m][0], v1 = acc[ai][bj][m][1]; u32x4 w;
                    if (mode == 3) { v0 = v0 + cr[bj][0]; v1 = v1 + cr[bj][1]; }
                    if (mode == 1) { w.x = cvt_pk_f16(v0[0], v0[1]); w.y = cvt_pk_f16(v0[2], v0[3]); w.z = cvt_pk_f16(v1[0], v1[1]); w.w = cvt_pk_f16(v1[2], v1[3]); }
                    else {
                        if (mode == 2) { const int sel = u.pn * 2 + bj;
                            if (sel == 0) {
#pragma unroll
                                for (int j = 0; j < 4; ++j) { v0[j] = ftanh(v0[j]); v1[j] = ftanh(v1[j]); } }
                            else if (sel >= 2) {
#pragma unroll
                                for (int j = 0; j < 4; ++j) { v0[j] = fsigmoid(v0[j]); v1[j] = fsigmoid(v1[j]); } } }
                        w.x = cvt_pk_bf16(v0[0], v0[1]); w.y = cvt_pk_bf16(v0[2], v0[3]); w.z = cvt_pk_bf16(v1[0], v1[1]); w.w = cvt_pk_bf16(v1[2], v1[3]); }
                    *(u32x4*)(rowp + bj * HALF) = w; } }
    }
};
struct EpiFold {
    static constexpr bool PERM = true;
    u16* O;
    __device__ __forceinline__ void operator()(const f32x4 (&acc)[2][2][4][2], const Unit& u, int wr, int wc, int fr, int fq) const {
        const int row0 = u.pm * BM + wr * 64 + fr, col0 = u.pn * HALF + wc * 32 + 8 * fq;
        const float sg = (fr & 1) ? -1.f : 1.f; const bool j0 = (u.pn == 0) && (wc == 0) && (fq == 0);
        u16* base = O + (size_t)u.bt * (512 * 1024);
#pragma unroll
        for (int ai = 0; ai < 2; ++ai)
#pragma unroll
            for (int m = 0; m < 4; ++m) { f32x4 v0 = acc[ai][0][m][0] + acc[ai][1][m][0] * sg, v1 = acc[ai][0][m][1] + acc[ai][1][m][1] * sg;
                if (j0) v0[0] = (fr & 1) ? 0.f : acc[ai][0][m][0][0];
                u32x4 w; w.x = cvt_pk_bf16(v0[0], v0[1]); w.y = cvt_pk_bf16(v0[2], v0[3]); w.z = cvt_pk_bf16(v1[0], v1[1]); w.w = cvt_pk_bf16(v1[2], v1[3]);
                *(u32x4*)(base + (size_t)(row0 + ai * HALF + m * 16) * 1024 + col0) = w; }
    }
};
struct EpiGLU {
    static constexpr bool PERM = true;
    u16* O;
    __device__ __forceinline__ void operator()(const f32x4 (&acc)[2][2][4][2], const Unit& u, int wr, int wc, int fr, int fq) const {
        const int row0 = u.pm * BM + wr * 64 + fr, col0 = u.pn * HALF + wc * 32 + 8 * fq;
#pragma unroll
        for (int ai = 0; ai < 2; ++ai)
#pragma unroll
            for (int m = 0; m < 4; ++m) { u16* rowp = O + (size_t)(row0 + ai * HALF + m * 16) * FF + col0; float o[8];
#pragma unroll
                for (int n = 0; n < 2; ++n)
#pragma unroll
                    for (int j = 0; j < 4; ++j) { const float g = acc[ai][0][m][n][j], up = acc[ai][1][m][n][j]; o[n * 4 + j] = g * fsigmoid(g) * up; }
                u32x4 w; w.x = cvt_pk_bf16(o[0], o[1]); w.y = cvt_pk_bf16(o[2], o[3]); w.z = cvt_pk_bf16(o[4], o[5]); w.w = cvt_pk_bf16(o[6], o[7]);
                *(u32x4*)rowp = w; }
    }
};

template <class Epi, bool MIRROR = false>
__device__ __forceinline__ void gemm_phase(LAS unsigned char* lds, const Sched& S, const Epi& E) {
    const int tid = threadIdx.x, wid = __builtin_amdgcn_readfirstlane(tid >> 6), lane = tid & 63, wr = wid >> 2, wc = wid & 3, fr = lane & 15, fq = lane >> 4;
    const int K = S.K, nt = K / BK;
    unsigned voffA[2], voffB[2]; int voffB2[2];
#pragma unroll
    for (int i = 0; i < 2; ++i) { int R, C; stage_rc(tid * 16 + i * 8192, R, C); const int Rb = Epi::PERM ? ((R & ~31) + perm32(R & 31)) : R;
        voffA[i] = (unsigned)(R * S.lda + C) * 2u; voffB[i] = (unsigned)(Rb * S.ldb + C) * 2u; voffB2[i] = (C - Rb * S.ldb) * 2; }
    const size_t kstep = (size_t)(BK * 2);
    const size_t hstepA = (size_t)HALF * S.lda * 2, hstepB = (size_t)HALF * S.ldb * 2;
    const unsigned ldsw = (unsigned)wid * 1024u;
    const int aoff = lds_byte(wr * 64 + fr, fq * 8), boff = lds_byte(wc * 32 + fr, fq * 8);
#define PG8_SA(b, h) (((b) * 2 + (h)) * HTB)
#define PG8_SB(b, h) ((4 + (b) * 2 + (h)) * HTB)
#define PG8_STAGE(bufoff, gbase, voff) do { _Pragma("unroll") for (int _i = 0; _i < 2; ++_i) \
        __builtin_amdgcn_global_load_lds((const unsigned*)((const char*)(gbase) + (voff)[_i]), (LAS unsigned*)(lds + (bufoff) + ldsw + _i * 8192), 16, 0, 0); } while (0)
#define PG8_STAGE_BH(bufoff, p1, p2) do { if (MIRROR) { _Pragma("unroll") for (int _i = 0; _i < 2; ++_i) \
        __builtin_amdgcn_global_load_lds((const unsigned*)((const char*)(p2) + voffB2[_i]), (LAS unsigned*)(lds + (bufoff) + ldsw + _i * 8192), 16, 0, 0); } else PG8_STAGE(bufoff, (p1) + hstepB, voffB); } while (0)
#define PG8_LDA(dst, b, h) do { _Pragma("unroll") for (int m = 0; m < 4; ++m) _Pragma("unroll") for (int k = 0; k < 2; ++k) dst[m][k] = *(const LAS bf16x8*)(lds + PG8_SA(b, h) + aoff + m * 2048 + k * 1024); } while (0)
#define PG8_LDB(dst, b, h) do { _Pragma("unroll") for (int n = 0; n < 2; ++n) _Pragma("unroll") for (int k = 0; k < 2; ++k) dst[n][k] = *(const LAS bf16x8*)(lds + PG8_SB(b, h) + boff + n * 2048 + k * 1024); } while (0)
#define PG8_MMA(ai, bj, At, Bt) do { __builtin_amdgcn_s_setprio(1); _Pragma("unroll") for (int m = 0; m < 4; ++m) _Pragma("unroll") for (int n = 0; n < 2; ++n) _Pragma("unroll") for (int k = 0; k < 2; ++k) \
        acc[ai][bj][m][n] = __builtin_amdgcn_mfma_f32_16x16x32_bf16(Bt[n][k], At[m][k], acc[ai][bj][m][n], 0, 0, 0); __builtin_amdgcn_s_setprio(0); } while (0)
#define PG8_WAIT_V(n) asm volatile("s_waitcnt vmcnt(" #n ")" ::: "memory")
#define PG8_WAIT_L(n) asm volatile("s_waitcnt lgkmcnt(" #n ")" ::: "memory")
#define PG8_BAR __builtin_amdgcn_s_barrier()
#define PG8_SCHED __builtin_amdgcn_sched_barrier(0)
    Unit cur, nxt; int ui = 0;
    if (!S.next(0, cur)) return;
    f32x4 acc[2][2][4][2];
#pragma unroll
    for (int a = 0; a < 2; ++a)
#pragma unroll
        for (int b = 0; b < 2; ++b)
#pragma unroll
            for (int m = 0; m < 4; ++m)
#pragma unroll
                for (int n = 0; n < 2; ++n) acc[a][b][m][n] = (f32x4){0.f, 0.f, 0.f, 0.f};
    bf16x8 At[4][2], B0[2][2], B1[2][2];
    const char* cA = cur.A; const char* cB = cur.B; const char* cB2 = cur.B2;
    PG8_STAGE(PG8_SB(0, 0), cB, voffB); PG8_STAGE(PG8_SA(0, 0), cA, voffA); PG8_STAGE_BH(PG8_SB(0, 1), cB, cB2); PG8_STAGE(PG8_SA(0, 1), cA + hstepA, voffA);
    if (wr == 1) PG8_BAR;
    PG8_WAIT_V(4); PG8_BAR;
    PG8_STAGE(PG8_SB(1, 0), cB + kstep, voffB); PG8_STAGE(PG8_SA(1, 0), cA + kstep, voffA); PG8_STAGE_BH(PG8_SB(1, 1), cB + kstep, cB2 + kstep);
    PG8_WAIT_V(6); PG8_BAR;
    for (;;) {
        const bool has_next = S.next(ui + 1, nxt);
        const char* nA = has_next ? nxt.A : cA; const char* nB = has_next ? nxt.B : cB; const char* nB2 = has_next ? nxt.B2 : cB2;
        for (int t = 0; t < nt; t += 2) {
            const bool last = (t == nt - 2);
            const char* a1 = cA + (size_t)(t + 1) * kstep;
            const char* a2 = last ? nA : cA + (size_t)(t + 2) * kstep; const char* b2 = last ? nB : cB + (size_t)(t + 2) * kstep;
            const char* a3 = a2 + kstep; const char* b3 = b2 + kstep;
            const char* b2m = last ? nB2 : cB2 + (size_t)(t + 2) * kstep; const char* b3m = b2m + kstep;
            PG8_LDB(B0, 0, 0); PG8_SCHED; PG8_LDA(At, 0, 0); PG8_STAGE(PG8_SA(1, 1), a1 + hstepA, voffA);
            PG8_WAIT_L(8); PG8_BAR; PG8_WAIT_L(0); PG8_MMA(0, 0, At, B0); PG8_BAR; PG8_SCHED;
            PG8_LDB(B1, 0, 1); PG8_STAGE(PG8_SB(0, 0), b2, voffB);
            PG8_BAR; PG8_WAIT_L(0); PG8_MMA(0, 1, At, B1); PG8_BAR;
            PG8_LDA(At, 0, 1); PG8_STAGE(PG8_SA(0, 0), a2, voffA);
            PG8_BAR; PG8_WAIT_L(0); PG8_MMA(1, 0, At, B0); PG8_BAR; PG8_SCHED;
            PG8_STAGE_BH(PG8_SB(0, 1), b2, b2m);
            PG8_WAIT_V(6); PG8_BAR; PG8_MMA(1, 1, At, B1); PG8_BAR;
            PG8_LDB(B0, 1, 0); PG8_SCHED; PG8_LDA(At, 1, 0); PG8_STAGE(PG8_SA(0, 1), a2 + hstepA, voffA);
            PG8_WAIT_L(8); PG8_BAR; PG8_WAIT_L(0); PG8_MMA(0, 0, At, B0); PG8_BAR; PG8_SCHED;
            PG8_LDB(B1, 1, 1); PG8_STAGE(PG8_SB(1, 0), b3, voffB);
            PG8_BAR; PG8_WAIT_L(0); PG8_MMA(0, 1, At, B1); PG8_BAR;
            PG8_LDA(At, 1, 1); PG8_STAGE(PG8_SA(1, 0), a3, voffA);
            PG8_BAR; PG8_WAIT_L(0); PG8_MMA(1, 0, At, B0); PG8_BAR; PG8_SCHED;
            PG8_STAGE_BH(PG8_SB(1, 1), b3, b3m);
            PG8_WAIT_V(6); PG8_BAR; PG8_MMA(1, 1, At, B1); PG8_BAR;
        }
        E(acc, cur, wr, wc, fr, fq);
        if (!has_next) break;
#pragma unroll
        for (int a = 0; a < 2; ++a)
#pragma unroll
            for (int b = 0; b < 2; ++b)
#pragma unroll
                for (int m = 0; m < 4; ++m)
#pragma unroll
                    for (int n = 0; n < 2; ++n) acc[a][b][m][n] = (f32x4){0.f, 0.f, 0.f, 0.f};
        cur = nxt; cA = nA; cB = nB; cB2 = nB2; ++ui;
    }
    PG8_WAIT_V(0);
    if (wr == 0) PG8_BAR;
    PG8_BAR;
#undef PG8_SA
#undef PG8_SB
#undef PG8_STAGE
#undef PG8_STAGE_BH
#undef PG8_LDA
#undef PG8_LDB
#undef PG8_MMA
#undef PG8_WAIT_V
#undef PG8_WAIT_L
#undef PG8_BAR
#undef PG8_SCHED
}
}

__device__ __forceinline__ void tr_tile(const float* __restrict__ W, int ldw, int k0, int n0, u16* WT, int ldt, int drow0, int dcol0, const float* kscale, LAS float* scr, int lane) {
#pragma unroll 8
    for (int i = 0; i < 32; ++i) { const int kk = 2 * i + (lane >> 5); float v = W[(size_t)(k0 + kk) * ldw + n0 + (lane & 31)]; if (kscale) v *= kscale[k0 + kk]; scr[kk * 33 + (lane & 31)] = v; }
    asm volatile("s_waitcnt lgkmcnt(0)" ::: "memory");
    const int c = lane & 7;
#pragma unroll
    for (int j = 0; j < 4; ++j) { const int n = (lane >> 3) + 8 * j; const LAS float* s = scr + (8 * c) * 33 + n;
        u32x4 o; o.x = cvt_pk_bf16(s[0 * 33], s[1 * 33]); o.y = cvt_pk_bf16(s[2 * 33], s[3 * 33]); o.z = cvt_pk_bf16(s[4 * 33], s[5 * 33]); o.w = cvt_pk_bf16(s[6 * 33], s[7 * 33]);
        *(u32x4*)(WT + (size_t)(drow0 + n) * ldt + dcol0 + 8 * c) = o; }
    asm volatile("s_waitcnt lgkmcnt(0)" ::: "memory");
}

#define VIDX(lane, k) (2 * (lane) + 128 * ((k) >> 1) + ((k) & 1))
__device__ __forceinline__ void rms_row(const float* xrow, const f32x4 (&gv)[4], f32x4 (&v)[4], int lane) {
    const f32x4* xr = (const f32x4*)xrow; float s = 0.f;
#pragma unroll
    for (int k = 0; k < 4; ++k) { v[k] = xr[VIDX(lane, k)]; s += (v[k].x * v[k].x + v[k].y * v[k].y) + (v[k].z * v[k].z + v[k].w * v[k].w); }
    const float rstd = rsqrtf(wave_sum(s) * (1.f / D) + 1e-6f);
#pragma unroll
    for (int k = 0; k < 4; ++k) v[k] = v[k] * rstd * gv[k];
}
__device__ __forceinline__ void rms_row_b(const u16* xrow, const f32x4 (&gv)[4], f32x4 (&v)[4], int lane) {
    const u32x4* xr = (const u32x4*)xrow + lane; float s = 0.f;
#pragma unroll
    for (int j = 0; j < 2; ++j) { const u32x4 t = xr[64 * j];
        v[2 * j] = (f32x4){bf2f(t.x & 0xffffu), bf2f(t.x >> 16), bf2f(t.y & 0xffffu), bf2f(t.y >> 16)}; v[2 * j + 1] = (f32x4){bf2f(t.z & 0xffffu), bf2f(t.z >> 16), bf2f(t.w & 0xffffu), bf2f(t.w >> 16)}; }
#pragma unroll
    for (int k = 0; k < 4; ++k) s += (v[k].x * v[k].x + v[k].y * v[k].y) + (v[k].z * v[k].z + v[k].w * v[k].w);
    const float rstd = rsqrtf(wave_sum(s) * (1.f / D) + 1e-6f);
#pragma unroll
    for (int k = 0; k < 4; ++k) v[k] = v[k] * rstd * gv[k];
}
__device__ __forceinline__ void store_row_bf16(u16* orow, const f32x4 (&v)[4], int lane) {
    u32x4* o16 = (u32x4*)orow + lane;
#pragma unroll
    for (int j = 0; j < 2; ++j) { u32x4 w; w.x = cvt_pk_bf16(v[2 * j].x, v[2 * j].y); w.y = cvt_pk_bf16(v[2 * j].z, v[2 * j].w); w.z = cvt_pk_bf16(v[2 * j + 1].x, v[2 * j + 1].y); w.w = cvt_pk_bf16(v[2 * j + 1].z, v[2 * j + 1].w); o16[64 * j] = w; }
}

__device__ __forceinline__ void phase_rmsnorm_bf16(const float* x, const float* g, u16* out, int ostride) {
    const int lane = threadIdx.x & 63, gw = blockIdx.x * 8 + (threadIdx.x >> 6), NGW = gridDim.x * 8;
    f32x4 gv[4];
#pragma unroll
    for (int j = 0; j < 4; ++j) gv[j] = ((const f32x4*)g)[VIDX(lane, j)];
    for (int row = gw; row < M; row += NGW) { f32x4 v[4]; rms_row(x + (size_t)row * D, gv, v, lane); store_row_bf16(out + (size_t)row * ostride, v, lane); }
}
__device__ __forceinline__ void phase_rmsnorm_b2b(const u16* x, const float* g, u16* out) {
    const int lane = threadIdx.x & 63, gw = blockIdx.x * 8 + (threadIdx.x >> 6), NGW = gridDim.x * 8;
    f32x4 gv[4];
#pragma unroll
    for (int j = 0; j < 4; ++j) gv[j] = ((const f32x4*)g)[VIDX(lane, j)];
    for (int row = gw; row < M; row += NGW) { f32x4 v[4]; rms_row_b(x + (size_t)row * D, gv, v, lane); store_row_bf16(out + (size_t)row * D, v, lane); }
}
__device__ __forceinline__ void phase_rmsnorm_final(const u16* x, float* out, const float* g) {
    const int lane = threadIdx.x & 63, gw = blockIdx.x * 8 + (threadIdx.x >> 6), NGW = gridDim.x * 8;
    f32x4 gv[4];
#pragma unroll
    for (int j = 0; j < 4; ++j) gv[j] = ((const f32x4*)g)[VIDX(lane, j)];
    for (int row = gw; row < M; row += NGW) { f32x4 v[4]; rms_row_b(x + (size_t)row * D, gv, v, lane); f32x4* o = (f32x4*)(out + (size_t)row * D);
#pragma unroll
        for (int j = 0; j < 4; ++j) o[VIDX(lane, j)] = v[j]; }
}

__device__ __forceinline__ void phase_prep(const Params& p, LAS unsigned char* lds) {
    const int tid = threadIdx.x, lane = tid & 63, wave = tid >> 6;
    const int gw = blockIdx.x * 8 + wave, NGW = gridDim.x * 8;
    const int gt = blockIdx.x * 512 + tid, NGT = gridDim.x * 512;
    unsigned char* ws = p.ws;
    LAS float* scr = (LAS float*)(lds + wave * 8448);
#define TR_JOB(SRC, LDW, KK, NN, DST, LDT, DROWEXPR, DCOL0, KSCALE) \
    { const int nblk = (NN) / 32, nit = ((KK) / 64) * nblk; if (it < nit) { const int kb = it / nblk, nb = it % nblk, k0 = 64 * kb, n0 = 32 * nb; \
        tr_tile(SRC, LDW, k0, n0, (u16*)(DST), LDT, (DROWEXPR), (DCOL0) + k0, KSCALE, scr, lane); continue; } it -= nit; }
    constexpr int NIT_SQ = 16 * 32, NIT_GU = 16 * 88, NIT_DN = 44 * 32, NIT_L64 = 16 * 2, NIT_L128 = 16 * 4, NIT_G2 = 2 * 32;
    constexpr int NITEMS = NIT_SQ + 2 * (2 * NIT_GU + NIT_DN) + 3 * NIT_SQ + NIT_SQ + 2 * (4 * NIT_L64) + 2 * NIT_L128 + NIT_G2;
    for (int it0 = gw; it0 < NITEMS; it0 += NGW) {
        int it = it0;
        TR_JOB(p.in[4], D, D, D, ws + W_WOUT, D, n0, 0, nullptr)
        TR_JOB(p.in[21], FF, D, FF, ws + W_GU0, D, (n0 / 128) * 256 + (n0 % 128), 0, nullptr)
        TR_JOB(p.in[22], FF, D, FF, ws + W_GU0, D, (n0 / 128) * 256 + 128 + (n0 % 128), 0, nullptr)
        TR_JOB(p.in[21] + (size_t)D * FF, FF, D, FF, ws + W_GU1, D, (n0 / 128) * 256 + (n0 % 128), 0, nullptr)
        TR_JOB(p.in[22] + (size_t)D * FF, FF, D, FF, ws + W_GU1, D, (n0 / 128) * 256 + 128 + (n0 % 128), 0, nullptr)
        TR_JOB(p.in[23], D, FF, D, ws + W_D0, FF, n0, 0, nullptr)
        TR_JOB(p.in[23] + (size_t)D * FF, D, FF, D, ws + W_D1, FF, n0, 0, nullptr)
        TR_JOB(p.in[6], D, D, D, ws + W_RKV, D, n0, 0, nullptr)
        TR_JOB(p.in[6] + (size_t)D * D, D, D, D, ws + W_RKV, D, 1024 + n0, 0, nullptr)
        TR_JOB(p.in[6] + (size_t)2 * D * D, D, D, D, ws + W_RKV, D, 2048 + n0, 0, nullptr)
        TR_JOB(p.in[7], D, D, D, ws + W_WO, D, n0, 0, nullptr)
        TR_JOB(p.in[9], 64, D, 64, ws + W_LI, 2048, n0, 0, nullptr)
        TR_JOB(p.in[9], 64, D, 64, ws + W_LI, 2048, n0, 1024, p.in[5] + 3 * D)
        TR_JOB(p.in[9] + 65536, 64, D, 64, ws + W_LI, 2048, 64 + n0, 0, nullptr)
        TR_JOB(p.in[9] + 65536, 64, D, 64, ws + W_LI, 2048, 64 + n0, 1024, p.in[5] + 3 * D)
        TR_JOB(p.in[12], 64, D, 64, ws + W_LI, 2048, 128 + n0, 0, nullptr)
        TR_JOB(p.in[12], 64, D, 64, ws + W_LI, 2048, 128 + n0, 1024, p.in[5] + 4 * D)
        TR_JOB(p.in[12] + 65536, 64, D, 64, ws + W_LI, 2048, 192 + n0, 0, nullptr)
        TR_JOB(p.in[12] + 65536, 64, D, 64, ws + W_LI, 2048, 192 + n0, 1024, p.in[5] + 4 * D)
        TR_JOB(p.in[14], 128, D, 128, ws + W_LI, 2048, 256 + n0, 0, nullptr)
        TR_JOB(p.in[14], 128, D, 128, ws + W_LI, 2048, 256 + n0, 1024, p.in[5] + 5 * D)
        TR_JOB(p.in[15], D, 128, D, ws + W_LO, 256, n0, 0, nullptr)
    }
#undef TR_JOB
    { const u32x4 z = {0u, 0u, 0u, 0u};
      u32x4* zl = (u32x4*)(ws + W_LI + (size_t)384 * 2048 * 2);
      for (int i = gt; i < 128 * 2048 * 2 / 16; i += NGT) zl[i] = z;
      for (int i = gt; i < 1024 * 16; i += NGT) { const int row = i >> 4, c16 = i & 15; *(u32x4*)(ws + W_LO + (size_t)row * 512 + 256 + c16 * 16) = z; } }
    { u16* dc = (u16*)(ws + W_DFTC);
      for (int i = gt; i < 512 * 256 / 8; i += NGT) { const int m = i >> 5, k0 = (i & 31) * 8, f = m >> 1, cs = m & 1; float v[8];
#pragma unroll
          for (int e = 0; e < 8; ++e) { const float a = (float)((f * (k0 + e)) & 255) * (1.0f / 128.0f); v[e] = cs ? sinpif(a) : cospif(a); }
          u32x4 o; o.x = cvt_pk_bf16(v[0], v[1]); o.y = cvt_pk_bf16(v[2], v[3]); o.z = cvt_pk_bf16(v[4], v[5]); o.w = cvt_pk_bf16(v[6], v[7]);
          *(u32x4*)(dc + (size_t)m * 256 + k0) = o; }
      u16* wsq = (u16*)(ws + W_WS);
      const float alpha = 0.0013810679f;
      for (int i = gt; i < 2048 * 2048 / 8; i += NGT) { const int s = i >> 8, k0 = (i & 255) * 8, cs = k0 >> 10, sp0 = k0 & 1023; float v[8];
#pragma unroll
          for (int e = 0; e < 8; ++e) { const float a = (float)((s * (sp0 + e)) & 2047) * (1.0f / 1024.0f); v[e] = cs ? -alpha * sinpif(a) : alpha * cospif(a); }
          u32x4 o; o.x = cvt_pk_bf16(v[0], v[1]); o.y = cvt_pk_bf16(v[2], v[3]); o.z = cvt_pk_bf16(v[4], v[5]); o.w = cvt_pk_bf16(v[6], v[7]);
          *(u32x4*)(wsq + (size_t)s * 2048 + k0) = o; } }
    phase_rmsnorm_bf16(p.in[0], p.in[1], (u16*)(ws + A_H0), D);
}

__device__ __forceinline__ void phase_shift(const Params& p) {
    const int lane = threadIdx.x & 63, gw = blockIdx.x * 8 + (threadIdx.x >> 6), NGW = gridDim.x * 8;
    const u16* x = (const u16*)p.out; const float* g = p.in[1] + D; const float* mu = p.in[5];
    u16* hx = (u16*)(p.ws + A_HX); u16* xs = (u16*)(p.ws + A_XS);
    f32x4 gv[4], mr[4], mk[4], mv[4];
#pragma unroll
    for (int j = 0; j < 4; ++j) { gv[j] = ((const f32x4*)g)[VIDX(lane, j)]; mr[j] = ((const f32x4*)mu)[VIDX(lane, j)]; mk[j] = ((const f32x4*)(mu + D))[VIDX(lane, j)]; mv[j] = ((const f32x4*)(mu + 2 * D))[VIDX(lane, j)]; }
    const f32x4 z4 = {0.f, 0.f, 0.f, 0.f};
    for (int grp = gw; grp < M / 16; grp += NGW) {
        const int t0 = grp * 16, s0 = t0 & (SEQ - 1);
        f32x4 hp[4], hc[4], hn[4];
        if (s0 > 0) rms_row_b(x + (size_t)(t0 - 1) * D, gv, hp, lane); else { hp[0] = z4; hp[1] = z4; hp[2] = z4; hp[3] = z4; }
        rms_row_b(x + (size_t)t0 * D, gv, hc, lane);
        for (int i = 0; i < 16; ++i) {
            const int t = t0 + i;
            if (s0 + i + 1 < SEQ) rms_row_b(x + (size_t)(t + 1) * D, gv, hn, lane); else { hn[0] = z4; hn[1] = z4; hn[2] = z4; hn[3] = z4; }
            f32x4 xx[4], o[4];
#pragma unroll
            for (int j = 0; j < 4; ++j) xx[j] = (hp[j] + hn[j]) * 0.5f - hc[j];
            store_row_bf16(hx + (size_t)t * 2048, hc, lane);
            store_row_bf16(hx + (size_t)t * 2048 + D, xx, lane);
#pragma unroll
            for (int j = 0; j < 4; ++j) o[j] = hc[j] + xx[j] * mr[j];
            store_row_bf16(xs + (size_t)t * D, o, lane);
#pragma unroll
            for (int j = 0; j < 4; ++j) o[j] = hc[j] + xx[j] * mk[j];
            store_row_bf16(xs + (size_t)M * D + (size_t)t * D, o, lane);
#pragma unroll
            for (int j = 0; j < 4; ++j) o[j] = hc[j] + xx[j] * mv[j];
            store_row_bf16(xs + (size_t)2 * M * D + (size_t)t * D, o, lane);
#pragma unroll
            for (int j = 0; j < 4; ++j) { hp[j] = hc[j]; hc[j] = hn[j]; }
        }
    }
}

__device__ __forceinline__ void phase_postscan(const Params& p) {
    const int tid = threadIdx.x, cg8 = tid & 127;
    const h16* yf = (const h16*)(p.ws + A_YF); const h16* yb = (const h16*)(p.ws + A_YB); const h16* vv = (const h16*)(p.ws + A_V);
    const u16* gg = (const u16*)(p.ws + A_G); const float* bon = (const float*)(p.ws + A_BON); u16* outp = (u16*)(p.ws + A_GATED);
    float lw[8], lb[8];
#pragma unroll
    for (int e = 0; e < 8; ++e) { lw[e] = p.in[19][cg8 * 8 + e]; lb[e] = p.in[20][cg8 * 8 + e]; }
    for (int tok = blockIdx.x * 4 + (tid >> 7); tok < M; tok += gridDim.x * 4) {
        const size_t o = (size_t)tok * D + cg8 * 8;
        const h16x8 a = *(const h16x8*)(yf + o), b = *(const h16x8*)(yb + o), v8 = *(const h16x8*)(vv + o);
        const u32x4 g4 = *(const u32x4*)(gg + o);
        const float bs = bon[(size_t)tok * 16 + (cg8 >> 3)] + bon[(size_t)M * 16 + (size_t)tok * 16 + (cg8 >> 3)];
        float y[8], s = 0.f;
#pragma unroll
        for (int e = 0; e < 8; ++e) { y[e] = (float)a[e] + (float)b[e]; s += y[e]; }
        s += __shfl_xor(s, 1); s += __shfl_xor(s, 2); s += __shfl_xor(s, 4);
        const float mean = s * (1.f / 64.f); float q = 0.f;
#pragma unroll
        for (int e = 0; e < 8; ++e) { y[e] -= mean; q += y[e] * y[e]; }
        q += __shfl_xor(q, 1); q += __shfl_xor(q, 2); q += __shfl_xor(q, 4);
        const float rstd = rsqrtf(q * (1.f / 64.f) + 64e-5f);
        float r[8];
#pragma unroll
        for (int e = 0; e < 8; ++e) { const unsigned gw = (e & 1) ? (g4[e >> 1] >> 16) : (g4[e >> 1] & 0xffffu);
            const float yn = y[e] * rstd * lw[e] + lb[e]; r[e] = (yn + bs * (float)v8[e]) * bf2f(gw); }
        u32x4 w; w.x = cvt_pk_bf16(r[0], r[1]); w.y = cvt_pk_bf16(r[2], r[3]); w.z = cvt_pk_bf16(r[4], r[5]); w.w = cvt_pk_bf16(r[6], r[7]);
        *(u32x4*)(outp + o) = w;
    }
}

constexpr int RP = 144, A3P = 80;
constexpr int CS_KH = 0, CS_RH = 2304, CS_KC = 4608, CS_BC = 6912, CS_GL = 9216, CS_BN = 9472, CS_BYTES = 9728;
static_assert(12 * CS_BYTES + 2560 <= 131072, "scan LDS map");
typedef _Float16 h16x4 __attribute__((ext_vector_type(4)));
typedef short s16x4 __attribute__((ext_vector_type(4)));

__device__ __forceinline__ bf16x8 mk8(u32x2 lo, u32x2 hi) { const u32x4 t = {lo.x, lo.y, hi.x, hi.y}; return __builtin_bit_cast(bf16x8, t); }
__device__ __forceinline__ u32x2 pk4(float a, float b, float c, float d) { u32x2 r; r.x = cvt_pk_bf16(a, b); r.y = cvt_pk_bf16(c, d); return r; }
__device__ __forceinline__ bf16x8 lo8(const f32x4 x) { const u32x2 z2 = {0u, 0u}; return mk8(pk4(x[0], x[1], x[2], x[3]), z2); }
#define MFMA16(a, b, c) __builtin_amdgcn_mfma_f32_16x16x32_bf16(a, b, c, 0, 0, 0)
__device__ __forceinline__ float rowsum4(float x) {
    const unsigned u = __float_as_uint(x);
    auto p = __builtin_amdgcn_permlane32_swap(u, u, false, false);
    const float a = __uint_as_float(p[0]) + __uint_as_float(p[1]);
    const unsigned v = __float_as_uint(a);
    auto q = __builtin_amdgcn_permlane16_swap(v, v, false, false);
    return __uint_as_float(q[0]) + __uint_as_float(q[1]);
}
template <int CTRL> __device__ __forceinline__ float dpp1(float x) {
    return __uint_as_float((unsigned)__builtin_amdgcn_update_dpp((int)0x3f800000, (int)__float_as_uint(x), CTRL, 0xf, 0xf, false));
}

__device__ __forceinline__ void phase_scan(const Params& p, LAS unsigned char* lds) {
    const int tid = threadIdx.x, lane = tid & 63, wave = tid >> 6;
    const int d = wave >> 2, w = wave & 3, q = lane >> 4, n = lane & 15;
    const h16* Rg = (const h16*)(p.ws + A_R); const h16* Kg = (const h16*)(p.ws + A_K); const h16* Vg = (const h16*)(p.ws + A_V);
    const u16* mid = (const u16*)(p.ws + A_MID);
    h16* Yd = (h16*)(p.ws + (d ? A_YB : A_YF));
    float* bon = (float*)(p.ws + A_BON);
    {
        const int pair = blockIdx.x; const int b = pair >> 4, h = pair & 15, hc = h * 64;
        const size_t tokb = (size_t)b * SEQ;
        const int c4 = 16 * w + 4 * q;
        h16x2 kkslab[8];
#pragma unroll
        for (int e = 0; e < 8; ++e) kkslab[e] = (h16x2){(h16)p.in[16][hc + 16 * q + 2 * e], (h16)p.in[16][hc + 16 * q + 2 * e + 1]};
        LAS f32x4* cst = (LAS f32x4*)(lds + 12 * CS_BYTES + (wave * 4 + q) * 80);
        if (n == 0) {
            cst[0] = *(const f32x4*)(p.in[16] + hc + c4); cst[1] = *(const f32x4*)(p.in[8] + d * D + hc + c4); cst[2] = *(const f32x4*)(p.in[11] + d * D + hc + c4);
            cst[3] = *(const f32x4*)(p.in[17] + hc + c4); cst[4] = *(const f32x4*)(p.in[18] + hc + c4); }
        __syncthreads();
        bf16x8 Bw[2], Ba[2];
#pragma unroll
        for (int ks = 0; ks < 2; ++ks) { float tw[8], ta[8];
#pragma unroll
            for (int j = 0; j < 8; ++j) { const int kr = 32 * ks + 8 * q + j; tw[j] = p.in[10][(size_t)d * 65536 + (size_t)kr * D + hc + 16 * w + n]; ta[j] = p.in[13][(size_t)d * 65536 + (size_t)kr * D + hc + 16 * w + n]; }
            Bw[ks] = mk8(pk4(tw[0], tw[1], tw[2], tw[3]), pk4(tw[4], tw[5], tw[6], tw[7])); Ba[ks] = mk8(pk4(ta[0], ta[1], ta[2], ta[3]), pk4(ta[4], ta[5], ta[6], ta[7])); }
        f32x4 S[4];
#pragma unroll
        for (int rb = 0; rb < 4; ++rb) S[rb] = (f32x4){0.f, 0.f, 0.f, 0.f};
        struct Raw { h16x8 ks0, ks1; h16x4 k4, r4; u32x4 A0, A1, A2, A3; h16 v0, v1, v2, v3; };
        Raw rawX, rawY;
        auto tokbase = [&](int ci) -> int { return d ? (SEQ - 16 - 16 * ci) : 16 * ci; };
        auto load_raw = [&](int ci, Raw& rw) {
            const size_t tok = tokb + tokbase(ci) + (d ? 15 - n : n);
            rw.ks0 = *(const h16x8*)(Kg + tok * D + hc + 16 * q); rw.ks1 = *(const h16x8*)(Kg + tok * D + hc + 16 * q + 8);
            rw.k4 = *(const h16x4*)(Kg + tok * D + hc + c4); rw.r4 = *(const h16x4*)(Rg + tok * D + hc + c4);
            const size_t mo = tok * 512 + d * 64 + 8 * q;
            rw.A0 = *(const u32x4*)(mid + mo); rw.A1 = *(const u32x4*)(mid + mo + 32); rw.A2 = *(const u32x4*)(mid + mo + 128); rw.A3 = *(const u32x4*)(mid + mo + 160);
            const h16* vb = Vg + (tokb + tokbase(ci)) * D + hc + 16 * w + n; const int j0 = 4 * q;
            rw.v0 = vb[(size_t)(d ? 15 - j0 : j0) * D]; rw.v1 = vb[(size_t)(d ? 14 - j0 : j0 + 1) * D]; rw.v2 = vb[(size_t)(d ? 13 - j0 : j0 + 2) * D]; rw.v3 = vb[(size_t)(d ? 12 - j0 : j0 + 3) * D];
        };
        auto prep = [&](int slot, const Raw& rw) -> u32x2 {
            LAS unsigned char* cs = lds + (slot * 2 + d) * CS_BYTES;
            const u32x2 Bv = pk4((float)rw.v0, (float)rw.v1, (float)rw.v2, (float)rw.v3);
            float ss = 0.f;
            { const h16x2* k2a = (const h16x2*)&rw.ks0; const h16x2* k2b = (const h16x2*)&rw.ks1;
#pragma unroll
              for (int e = 0; e < 4; ++e) { const h16x2 pa = k2a[e] * kkslab[e], pb = k2b[e] * kkslab[4 + e]; ss = __builtin_amdgcn_fdot2(pa, pa, ss, false); ss = __builtin_amdgcn_fdot2(pb, pb, ss, false); } }
            ss = rowsum4(ss);
            const float rn = rsqrtf(fmaxf(ss, 1e-24f));
            f32x4 Dw = {0.f, 0.f, 0.f, 0.f}, Da = {0.f, 0.f, 0.f, 0.f};
            Dw = MFMA16(Bw[0], __builtin_bit_cast(bf16x8, rw.A0), Dw); Dw = MFMA16(Bw[1], __builtin_bit_cast(bf16x8, rw.A1), Dw);
            Da = MFMA16(Ba[0], __builtin_bit_cast(bf16x8, rw.A2), Da); Da = MFMA16(Ba[1], __builtin_bit_cast(bf16x8, rw.A3), Da);
            const f32x4 kk4c = cst[0], w0c = cst[1], a0c = cst[2], kac = cst[3], rkc = cst[4];
            float G[4], Gp[4], GLv[4], kh[4], rh[4], kc[4], bc[4], bsum = 0.f;
#pragma unroll
            for (int i = 0; i < 4; ++i) {
                const float dw1 = 1.0f + __expf(-(w0c[i] + Dw[i])), da1 = 1.0f + __expf(-(a0c[i] + Da[i])), rr = __builtin_amdgcn_rcpf(dw1 * da1);
                const float dec = __expf(-0.60653066f * (rr * da1)), av = rr * dw1;
                float g = dec;
                g *= dpp1<0x111>(g); g *= dpp1<0x112>(g); g *= dpp1<0x114>(g); g *= dpp1<0x118>(g);
                G[i] = g; Gp[i] = dpp1<0x111>(g); GLv[i] = dpp1<0x15F>(g);
                const float kf = (float)rw.k4[i], rf = (float)rw.r4[i], kkv = kf * kk4c[i] * rn, ig = __builtin_amdgcn_rcpf(g);
                const float bb = kkv * av, kd = kf * (1.0f + (av - 1.0f) * kac[i]);
                kh[i] = kkv * Gp[i]; rh[i] = rf * g; kc[i] = kd * ig; bc[i] = bb * ig;
                bsum += rf * kd * rkc[i]; }
            const int ro = n * RP + c4 * 2;
            *(LAS u32x2*)(cs + CS_KH + ro) = pk4(kh[0], kh[1], kh[2], kh[3]); *(LAS u32x2*)(cs + CS_RH + ro) = pk4(rh[0], rh[1], rh[2], rh[3]);
            *(LAS u32x2*)(cs + CS_KC + ro) = pk4(kc[0], kc[1], kc[2], kc[3]); *(LAS u32x2*)(cs + CS_BC + ro) = pk4(bc[0], bc[1], bc[2], bc[3]);
            if (n == 0) *(LAS f32x4*)(cs + CS_GL + c4 * 4) = (f32x4){GLv[0], GLv[1], GLv[2], GLv[3]};
            bsum = rowsum4(bsum);
            if (q == 0) *(LAS float*)(cs + CS_BN + (w * 16 + n) * 4) = bsum;
            return Bv;
        };
        auto gramT = [&](int slot, int gd, int part, LAS unsigned char* gt) {
            const LAS unsigned char* cs = lds + (slot * 2 + gd) * CS_BYTES;
            const f32x4 z4 = {0.f, 0.f, 0.f, 0.f}; const u32x2 z2 = {0u, 0u};
            bf16x8 fBC[2], fKH[2];
#pragma unroll
            for (int s2 = 0; s2 < 2; ++s2) { const int o = n * RP + 64 * s2 + 16 * q; fBC[s2] = *(const LAS bf16x8*)(cs + CS_BC + o); fKH[s2] = *(const LAS bf16x8*)(cs + CS_KH + o); }
            if (part == 0) {
                bf16x8 fKC[2], fRH[2];
#pragma unroll
                for (int s2 = 0; s2 < 2; ++s2) { const int o = n * RP + 64 * s2 + 16 * q; fKC[s2] = *(const LAS bf16x8*)(cs + CS_KC + o); fRH[s2] = *(const LAS bf16x8*)(cs + CS_RH + o); }
                f32x4 D1 = z4, D3 = z4, D4 = z4;
#pragma unroll
                for (int s2 = 0; s2 < 2; ++s2) { D1 = MFMA16(fKC[s2], fKH[s2], D1); D3 = MFMA16(fKC[s2], fRH[s2], D3); D4 = MFMA16(fBC[s2], fRH[s2], D4); }
                f32x4 a1, a3, a4;
#pragma unroll
                for (int i = 0; i < 4; ++i) { const int sidx = 4 * q + i; const bool lt = sidx < n, le = sidx <= n; a1[i] = lt ? D1[i] : 0.f; a3[i] = le ? D3[i] : 0.f; a4[i] = le ? D4[i] : 0.f; }
                *(LAS bf16x8*)(gt + lane * 16) = mk8(pk4(a1[0], a1[1], a1[2], a1[3]), z2);
                *(LAS bf16x8*)(gt + 1024 + lane * 16) = mk8(pk4(a3[0], a3[1], a3[2], a3[3]), pk4(a4[0], a4[1], a4[2], a4[3]));
            } else {
                f32x4 D2 = z4, D5 = z4;
#pragma unroll
                for (int s2 = 0; s2 < 2; ++s2) { D2 = MFMA16(fBC[s2], fKH[s2], D2); D5 = MFMA16(fKH[s2], fBC[s2], D5); }
                f32x4 Zd, Nd, R, Id;
#pragma unroll
                for (int i = 0; i < 4; ++i) { const int sidx = 4 * q + i; Zd[i] = (sidx < n) ? -D2[i] : 0.f; Nd[i] = (sidx > n) ? -D5[i] : 0.f; Id[i] = (sidx == n) ? 1.f : 0.f; }
                const bf16x8 oN = lo8(Nd), oZ = lo8(Zd);
                const f32x4 Z2 = MFMA16(oN, oZ, z4), N2 = MFMA16(oZ, oN, z4);
                const bf16x8 oN2 = lo8(N2), oZ2 = lo8(Z2);
                const f32x4 Z4 = MFMA16(oN2, oZ2, z4), N4 = MFMA16(oZ2, oN2, z4);
                const bf16x8 oN4 = lo8(N4);
                const f32x4 N8 = MFMA16(lo8(Z4), oN4, z4);
                R = Zd + Id;
                R = MFMA16(oN2, lo8(R), R); R = MFMA16(oN4, lo8(R), R); R = MFMA16(lo8(N8), lo8(R), R);
                *(LAS bf16x8*)(gt + 2048 + lane * 16) = lo8(R - Id);
            }
        };
        h16* const ybase = Yd + tokb * D + hc + 16 * w + n;
        int yro[4];
#pragma unroll
        for (int i = 0; i < 4; ++i) yro[i] = (d ? 15 - (4 * q + i) : 4 * q + i) * D;
        auto consume = [&](int ci, int slot, const u32x2 Bv, const LAS unsigned char* gt) {
            const LAS unsigned char* cs = lds + (slot * 2 + d) * CS_BYTES;
            const bf16x8 A1e = *(const LAS bf16x8*)(gt + lane * 16), A4e = *(const LAS bf16x8*)(gt + 1024 + lane * 16), TXe = *(const LAS bf16x8*)(gt + 2048 + lane * 16);
            const f32x4 z4 = {0.f, 0.f, 0.f, 0.f}; const u32x2 z2 = {0u, 0u};
            bf16x8 Bs[2], AK[2], AR[2];
#pragma unroll
            for (int s2 = 0; s2 < 2; ++s2) { Bs[s2] = mk8(pk4(S[2 * s2][0], S[2 * s2][1], S[2 * s2][2], S[2 * s2][3]), pk4(S[2 * s2 + 1][0], S[2 * s2 + 1][1], S[2 * s2 + 1][2], S[2 * s2 + 1][3]));
                const int o = n * RP + (32 * s2 + 4 * q) * 2;
                AK[s2] = mk8(*(const LAS u32x2*)(cs + CS_KH + o), *(const LAS u32x2*)(cs + CS_KH + o + 32)); AR[s2] = mk8(*(const LAS u32x2*)(cs + CS_RH + o), *(const LAS u32x2*)(cs + CS_RH + o + 32)); }
            f32x4 X = z4;
            X = MFMA16(AK[0], Bs[0], X); X = MFMA16(AK[1], Bs[1], X); X = MFMA16(A1e, mk8(Bv, z2), X);
            const f32x4 U = MFMA16(TXe, lo8(X), X);
            const bf16x8 Bvu = mk8(Bv, pk4(-U[0], -U[1], -U[2], -U[3]));
            f32x4 Y = z4;
            Y = MFMA16(AR[0], Bs[0], Y); Y = MFMA16(AR[1], Bs[1], Y); Y = MFMA16(A4e, Bvu, Y);
            const int tro = (4 * q + (n >> 2)) * RP + (n & 3) * 8;
#pragma unroll
            for (int rb = 0; rb < 4; ++rb) { const f32x4 g4 = *(const LAS f32x4*)(cs + CS_GL + (16 * rb + 4 * q) * 4);
                const s16x4 kT = __builtin_amdgcn_ds_read_tr16_b64_v4i16((LAS s16x4*)(cs + CS_KC + tro + 32 * rb)), bT = __builtin_amdgcn_ds_read_tr16_b64_v4i16((LAS s16x4*)(cs + CS_BC + tro + 32 * rb));
                const bf16x8 A3e = mk8(__builtin_bit_cast(u32x2, kT), __builtin_bit_cast(u32x2, bT));
                S[rb] = MFMA16(A3e, Bvu, S[rb]) * g4; }
            h16* yp = ybase + (size_t)tokbase(ci) * D;
#pragma unroll
            for (int i = 0; i < 4; ++i) yp[yro[i]] = (h16)Y[i];
        };
        LAS unsigned char* const gtb = lds + GT_OFF;
        constexpr int NIT = SEQ / 32;
        auto Gst = [&](int j) { gramT((j % 3) * 2 + (w & 1), w >> 1, d, gtb + ((j & 1) * 4 + (w & 1) * 2 + (w >> 1)) * 3072);
            if (w == 0 && lane < 32) { const int sub = lane >> 4, tt = lane & 15; const LAS float* bn = (const LAS float*)(lds + (((j % 3) * 2 + sub) * 2 + d) * CS_BYTES + CS_BN);
                bon[(size_t)d * M * 16 + (tokb + tokbase(2 * j + sub) + (d ? 15 - tt : tt)) * 16 + h] = (bn[tt] + bn[16 + tt]) + (bn[32 + tt] + bn[48 + tt]); } };
        u32x2 BvAX, BvAY, BvBX, BvBY, BvCX = {0u, 0u}, BvCY = {0u, 0u};
        load_raw(0, rawX); load_raw(1, rawY);
        BvAX = prep(0, rawX); BvAY = prep(1, rawY);
        load_raw(2, rawX); load_raw(3, rawY);
        __syncthreads();
        BvBX = prep(2, rawX); BvBY = prep(3, rawY);
        Gst(0);
        load_raw(4, rawX); load_raw(5, rawY);
        __syncthreads();
        for (int k = 0; k < NIT; ++k) {
            if (k + 2 < NIT) { const int sl = ((k + 2) % 3) * 2; BvCX = prep(sl, rawX); BvCY = prep(sl + 1, rawY); }
            if (k + 1 < NIT) Gst(k + 1);
            { const int sl = (k % 3) * 2; consume(2 * k, sl, BvAX, gtb + ((k & 1) * 4 + 0 * 2 + d) * 3072); consume(2 * k + 1, sl + 1, BvAY, gtb + ((k & 1) * 4 + 1 * 2 + d) * 3072); }
            if (k + 3 < NIT) { load_raw(2 * (k + 3), rawX); load_raw(2 * (k + 3) + 1, rawY); }
            BvAX = BvBX; BvAY = BvBY; BvBX = BvCX; BvBY = BvCY;
            __syncthreads();
        }
        __syncthreads();
    }
}

#define XB_TMO      128
#define XB_XCNT(j)  (256  + 64 * (j))
#define XB_XSUB(j)  (1280 + 64 * (j))
#define XB_XGEN(j)  (2304 + 64 * (j))
#define XB_TOP      3328
#define XB_TOPGEN   3392
#define XCD_BAR_WORDS 3456
#define XB_SPIN_CAP (1u << 22)
__device__ __forceinline__ unsigned xb_ld(unsigned* p)              { return __hip_atomic_load(p, __ATOMIC_RELAXED, __HIP_MEMORY_SCOPE_AGENT); }
__device__ __forceinline__ unsigned xb_add(unsigned* p, unsigned v) { return __hip_atomic_fetch_add(p, v, __ATOMIC_RELAXED, __HIP_MEMORY_SCOPE_AGENT); }
__device__ __forceinline__ unsigned xb_xcc_id() { return (unsigned)__builtin_amdgcn_s_getreg((3 << 11) | 20) & 0xFu; }
#define XB_SPIN(cond, bar) do { unsigned _sp = 0; while (cond) { __builtin_amdgcn_s_sleep(1); \
    if ((++_sp & 255u) == 0u) { if (xb_ld(&(bar)[XB_TMO])) break; if (_sp > XB_SPIN_CAP) { atomicAdd(&(bar)[XB_TMO], 1u); break; } } } } while (0)
struct XcdBarrier { unsigned* bar; unsigned x; volatile LAS unsigned* st; };
__device__ __forceinline__ XcdBarrier xcd_barrier_post(unsigned* bar, volatile LAS unsigned* st) {
    XcdBarrier b; b.bar = bar; b.x = xb_xcc_id(); b.st = st;
    if (threadIdx.x == 0) (void)xb_add(&bar[XB_XCNT(b.x)], 1u);
    return b;
}
__device__ __forceinline__ void xcd_barrier_complete(unsigned* bar, unsigned x, unsigned& nloc, unsigned& nx) {
    const unsigned G = gridDim.x * gridDim.y * gridDim.z;
    unsigned sum, cnt, mine, sp = 0u;
    for (;;) {
        sum = 0u; cnt = 0u; mine = 0u;
#pragma unroll
        for (unsigned j = 0; j < 16; ++j) { const unsigned c = xb_ld(&bar[XB_XCNT(j)]); sum += c; cnt += (c > 0u) ? 1u : 0u; mine = (j == x) ? c : mine; }
        if (sum == G) break;
        __builtin_amdgcn_s_sleep(1);
        if ((++sp & 255u) == 0u) { if (xb_ld(&bar[XB_TMO])) break; if (sp > XB_SPIN_CAP) { atomicAdd(&bar[XB_TMO], 1u); break; } }
    }
    nloc = mine > 0u ? mine : 1u; nx = cnt > 0u ? cnt : 1u;
}
__device__ __forceinline__ void xcd_barrier(const XcdBarrier& b) {
    asm volatile("s_waitcnt vmcnt(0)" ::: "memory");
    __syncthreads();
    if (threadIdx.x == 0) {
        unsigned* bar = b.bar;
        __builtin_amdgcn_s_waitcnt(0);
        unsigned nloc = b.st[0], nx = b.st[1];
        if (nloc == 0u) { xcd_barrier_complete(bar, b.x, nloc, nx); b.st[0] = nloc; b.st[1] = nx; }
        const unsigned old = xb_add(&bar[XB_XSUB(b.x)], 1u);
        const unsigned gen = old / nloc;
        if (old + 1u == (gen + 1u) * nloc) {
            __builtin_amdgcn_fence(__ATOMIC_RELEASE, "agent");
            asm volatile("s_waitcnt vmcnt(0)" ::: "memory");
            const unsigned og = xb_add(&bar[XB_TOP], 1u);
            const unsigned tg = og / nx;
            if (og + 1u == (tg + 1u) * nx) xb_add(&bar[XB_TOPGEN], 1u);
            else XB_SPIN(xb_ld(&bar[XB_TOPGEN]) == tg, bar);
            __builtin_amdgcn_fence(__ATOMIC_ACQUIRE, "agent");
            xb_add(&bar[XB_XGEN(b.x)], 1u);
            asm volatile("s_waitcnt vmcnt(0)" ::: "memory");
        } else {
            XB_SPIN(xb_ld(&bar[XB_XGEN(b.x)]) == gen, bar);
            __builtin_amdgcn_fence(__ATOMIC_ACQUIRE, "agent");
            asm volatile("s_waitcnt vmcnt(0)" ::: "memory");
        }
    }
    __syncthreads();
}

__device__ __forceinline__ void set_sched(pg8::Sched& S, const void* A0, const void* B0, int lda, int ldb, int K, int nM, int nN, int nB, int nB2, int aGrp,
                                          long aM, long aG, long aB1, long aB2, long bN, long bB1, long bB2) {
    S.A0 = (const char*)A0; S.B0 = (const char*)B0; S.lda = lda; S.ldb = ldb; S.K = K; S.nM = nM; S.nN = nN; S.nB = nB; S.nB2 = nB2; S.aGrp = aGrp;
    S.aM = aM; S.aG = aG; S.aB1 = aB1; S.aB2 = aB2; S.bN = bN; S.bB1 = bB1; S.bB2 = bB2; S.G = gridDim.x; S.c = blockIdx.x; S.mirTop = 0;
}

__global__ void __launch_bounds__(512, 2) mega(Params p) {
    extern __shared__ __attribute__((aligned(16))) unsigned char lds_dyn[];
    LAS unsigned char* lds = (LAS unsigned char*)lds_dyn;
    unsigned char* ws = p.ws;
    volatile LAS unsigned* xst = (volatile LAS unsigned*)(lds + 131072);
    if (threadIdx.x == 0) { xst[0] = 0u; xst[1] = 0u; }
    __syncthreads();
    XcdBarrier xb; xb.bar = (unsigned*)(ws + W_CTL); xb.x = 0; xb.st = xst;
    if (p.coop) xb = xcd_barrier_post((unsigned*)(ws + W_CTL), xst);
    if (p.coop == 2) cg::this_grid().sync();
#ifndef PROBE_MASK
#define PROBE_MASK 0
#endif
#define IN(ph) (p.ph_lo <= (ph) && (ph) < p.ph_hi)
#define REP(ph) for (int rep_ = 0; rep_ < (((PROBE_MASK >> (ph)) & 1) ? 2 : 1); ++rep_)
#define SEAM(ph) do { if (p.coop && (ph) + 1 < p.ph_hi) xcd_barrier(xb); else __syncthreads(); } while (0)
#define BIG (1 << 30)
    if (IN(0)) REP(0) { phase_prep(p, lds); SEAM(0); }
    if (IN(1)) REP(1) {
        pg8::Sched S; set_sched(S, ws + W_DFTC, ws + A_H0, 256, D, 256, 2, 8, 64, 4, BIG, 256L * 256 * 2, 0, 0, 0, 128L * D * 2, (long)SEQ * D * 2, 512);
        S.mirTop = (long)SEQ * D * 2;
        pg8::EpiFold E; E.O = (u16*)(ws + A_YT);
        pg8::gemm_phase<pg8::EpiFold, true>(lds, S, E);
        { const u16* h0 = (const u16*)(ws + A_H0); const u16* dc = (const u16*)(ws + W_DFTC); float* corr = (float*)(ws + A_CORR);
          for (int i = blockIdx.x * 512 + threadIdx.x; i < 16 * 1024; i += gridDim.x * 512) { const int b = i >> 10, np = i & 1023, g = np >> 8, f = np & 255;
              const u32x4* hp = (const u32x4*)(h0 + ((size_t)b * SEQ + 1024) * D + 256 * g); const u32x4* cp = (const u32x4*)(dc + (size_t)(2 * f) * 256); float a = 0.f;
              for (int k8 = 0; k8 < 32; ++k8) { const u32x4 hv = hp[k8], cv = cp[k8];
#pragma unroll
                  for (int e = 0; e < 4; ++e) a += bf2f(hv[e] & 0xffffu) * bf2f(cv[e] & 0xffffu) + bf2f(hv[e] >> 16) * bf2f(cv[e] >> 16); }
              corr[i] = 0.0013810679f * a; } }
        SEAM(1); }
    if (IN(2)) REP(2) {
        pg8::Sched S; set_sched(S, ws + W_WS, ws + A_YT, 2048, 2048, 2048, 8, 4, 16, 1, BIG, 256L * 2048 * 2, 0, 0, 0, 256L * 2048 * 2, 1024L * 2048 * 2, 0);
        pg8::Epi16 E; E.O0 = (u16*)(ws + A_F); E.O1 = nullptr; E.O2 = nullptr; E.ldc = D; E.grp = 4; E.mode = 3; E.bstride = (long)SEQ * D; E.corr = (const float*)(ws + A_CORR);
        pg8::gemm_phase<pg8::Epi16>(lds, S, E); SEAM(2); }
    if (IN(3)) REP(3) {
        pg8::Sched S; set_sched(S, ws + A_F, ws + W_WOUT, D, D, D, 128, 4, 1, 1, BIG, 256L * D * 2, 0, 0, 0, 256L * D * 2, 0, 0);
        pg8::EpiRes<true> E; E.out = (u16*)p.out; E.res = p.in[0];
        pg8::gemm_phase<pg8::EpiRes<true>>(lds, S, E); SEAM(3); }
    if (IN(4)) REP(4) { phase_rmsnorm_b2b((const u16*)p.out, p.in[2], (u16*)(ws + A_H0)); SEAM(4); }
    if (IN(5)) REP(5) {
        pg8::Sched S; set_sched(S, ws + A_H0, ws + W_GU0, D, D, D, 128, 22, 1, 1, BIG, 256L * D * 2, 0, 0, 0, 256L * D * 2, 0, 0);
        pg8::EpiGLU E; E.O = (u16*)(ws + A_ACT0);
        pg8::gemm_phase<pg8::EpiGLU>(lds, S, E); SEAM(5); }
    if (IN(6)) REP(6) {
        pg8::Sched S; set_sched(S, ws + A_ACT0, ws + W_D0, FF, FF, FF, 128, 4, 1, 1, BIG, 256L * FF * 2, 0, 0, 0, 256L * FF * 2, 0, 0);
        pg8::EpiRes<false> E; E.out = (u16*)p.out; E.res = p.out;
        pg8::gemm_phase<pg8::EpiRes<false>>(lds, S, E); SEAM(6); }
    if (IN(7)) REP(7) { phase_shift(p); SEAM(7); }
    if (IN(8)) REP(8) {
        pg8::Sched S; set_sched(S, ws + A_HX, ws + W_LI, 2048, 2048, 2048, 128, 2, 1, 1, BIG, 256L * 2048 * 2, 0, 0, 0, 256L * 2048 * 2, 0, 0);
        pg8::Epi16 E; E.O0 = (u16*)(ws + A_MID); E.O1 = nullptr; E.O2 = nullptr; E.ldc = 512; E.grp = 2; E.mode = 2; E.bstride = 0; E.corr = nullptr;
        pg8::gemm_phase<pg8::Epi16>(lds, S, E); SEAM(8); }
    if (IN(9)) REP(9) {
        pg8::Sched S; set_sched(S, ws + A_XS, ws + W_RKV, D, D, D, 128, 12, 1, 1, 4, 256L * D * 2, (long)M * D * 2, 0, 0, 256L * D * 2, 0, 0);
        pg8::Epi16 E; E.O0 = (u16*)(ws + A_R); E.O1 = (u16*)(ws + A_K); E.O2 = (u16*)(ws + A_V); E.ldc = D; E.grp = 4; E.mode = 1; E.bstride = 0; E.corr = nullptr;
        pg8::gemm_phase<pg8::Epi16>(lds, S, E); SEAM(9); }
    if (IN(10)) REP(10) {
        pg8::Sched S; set_sched(S, ws + A_MID + 512, ws + W_LO, 512, 256, 256, 128, 4, 1, 1, BIG, 256L * 512 * 2, 0, 0, 0, 256L * 256 * 2, 0, 0);
        pg8::Epi16 E; E.O0 = (u16*)(ws + A_G); E.O1 = nullptr; E.O2 = nullptr; E.ldc = D; E.grp = 4; E.mode = 0; E.bstride = 0; E.corr = nullptr;
        pg8::gemm_phase<pg8::Epi16>(lds, S, E); __syncthreads(); }
    if (IN(11)) REP(11) { phase_scan(p, lds); SEAM(11); }
    if (IN(12)) REP(12) { phase_postscan(p); SEAM(12); }
    if (IN(13)) REP(13) {
        pg8::Sched S; set_sched(S, ws + A_GATED, ws + W_WO, D, D, D, 128, 4, 1, 1, BIG, 256L * D * 2, 0, 0, 0, 256L * D * 2, 0, 0);
        pg8::EpiRes<false> E; E.out = (u16*)p.out; E.res = p.out;
        pg8::gemm_phase<pg8::EpiRes<false>>(lds, S, E); SEAM(13); }
    if (IN(14)) REP(14) { phase_rmsnorm_b2b((const u16*)p.out, p.in[2] + D, (u16*)(ws + A_H1)); SEAM(14); }
    if (IN(15)) REP(15) {
        pg8::Sched S; set_sched(S, ws + A_H1, ws + W_GU1, D, D, D, 128, 22, 1, 1, BIG, 256L * D * 2, 0, 0, 0, 256L * D * 2, 0, 0);
        pg8::EpiGLU E; E.O = (u16*)(ws + A_ACT1);
        pg8::gemm_phase<pg8::EpiGLU>(lds, S, E); SEAM(15); }
    if (IN(16)) REP(16) {
        pg8::Sched S; set_sched(S, ws + A_ACT1, ws + W_D1, FF, FF, FF, 128, 4, 1, 1, BIG, 256L * FF * 2, 0, 0, 0, 256L * FF * 2, 0, 0);
        pg8::EpiRes<false> E; E.out = (u16*)(ws + A_XF); E.res = p.out;
        pg8::gemm_phase<pg8::EpiRes<false>>(lds, S, E); SEAM(16); }
    if (IN(17)) REP(17) { phase_rmsnorm_final((const u16*)(ws + A_XF), p.out, p.in[3]); }
#undef IN
#undef SEAM
#undef BIG
}

extern "C" void kernel_launch(void* const* d_in, const int* in_sizes, int n_in, void* d_out, int out_size, void* d_ws, size_t ws_size, hipStream_t stream) {
    static int grid = 0;
    if (grid == 0) {
        if (n_in != 24 || out_size != M * D || ws_size < WS_NEED) { fprintf(stderr, "kernel_launch: unexpected shapes (n_in %d out %d ws %zu)\n", n_in, out_size, ws_size); grid = -1; return; }
        int dev = 0, cus = 0, per_cu = 0;
        hipGetDevice(&dev); hipDeviceGetAttribute(&cus, hipDeviceAttributeMultiprocessorCount, dev);
        if (hipFuncSetAttribute((const void*)mega, hipFuncAttributeMaxDynamicSharedMemorySize, LDS_BYTES) != hipSuccess) { fprintf(stderr, "hipFuncSetAttribute failed\n"); grid = -1; return; }
        hipOccupancyMaxActiveBlocksPerMultiprocessor(&per_cu, (const void*)mega, 512, LDS_BYTES);
        (void)hipGetLastError();
        if (per_cu < 1) per_cu = 1;
        grid = cus;
        if (grid != 256) { fprintf(stderr, "kernel_launch: built for a 256-CU device (scan phase: one (batch, head) pair per workgroup); got %d CUs\n", cus); grid = -1; return; }
    }
    if (grid < 0) return;
    Params p{};
    for (int i = 0; i < 24; ++i) p.in[i] = (const float*)d_in[i];
    p.out = (float*)d_out; p.ws = (unsigned char*)d_ws; p.pad = 0;
#if defined(MK_MULTI)
    p.coop = 0;
    for (int ph = 0; ph < NPHASE; ++ph) { p.ph_lo = ph; p.ph_hi = ph + 1; hipLaunchKernelGGL(mega, dim3(grid), dim3(512), LDS_BYTES, stream, p); }
#else
    if (hipMemsetAsync((unsigned char*)d_ws + W_CTL, 0, XCD_BAR_WORDS * 4, stream) != hipSuccess) { fprintf(stderr, "memset of barrier words failed\n"); return; }
    p.coop = 1; p.ph_lo = 0; p.ph_hi = NPHASE;
    void* args[] = {&p};
    hipError_t e = hipLaunchCooperativeKernel((const void*)mega, dim3(grid), dim3(512), args, LDS_BYTES, stream);
    if (e != hipSuccess) fprintf(stderr, "cooperative launch failed: %s (grid %d)\n", hipGetErrorString(e), grid);
#endif
}
```
